# Optimizing an MI355X kernel written in HIP

```python
import jax, jax.numpy as jnp
from jax import lax
import numpy as np

D_MODEL = 1024
BATCH = 8
SEQ = 4096
DEPTH = 1

HEAD_DIM = 64
RWKV_HEADS = 8
RWKV_WIDTH = RWKV_HEADS * HEAD_DIM
DECAY_LORA = 64
ICLR_LORA = 64
GATE_LORA = 128
ATTN_Q_HEADS = 8
ATTN_KV_HEADS = 2
ATTN_GROUPS = ATTN_Q_HEADS // ATTN_KV_HEADS
ATTN_Q_WIDTH = ATTN_Q_HEADS * HEAD_DIM
ATTN_KV_WIDTH = ATTN_KV_HEADS * HEAD_DIM
WINDOW = 128
BLOCK = 128
ROPE_THETA = 500000.0
ROPE_DIM = HEAD_DIM // 4
D_FF = -(-8 * D_MODEL // (3 * 256)) * 256
N_BRANCH = 2
RMS_EPS = 1e-6
GN_EPS = 64e-5
NEG_INF = -1e30
RWKV_SHIFT_WIDTH = 3 * RWKV_WIDTH + DECAY_LORA + ICLR_LORA + GATE_LORA
IN_WIDTH = RWKV_SHIFT_WIDTH + ATTN_Q_WIDTH + 2 * ATTN_KV_WIDTH + N_BRANCH * D_MODEL

kernel_name = "hybrid_rwkv7_swa_sink_adaln_block"


def rms_norm(x, gain, eps=RMS_EPS):
    x32 = x.astype(jnp.float32)
    inv = lax.rsqrt(jnp.mean(x32 * x32, axis=-1, keepdims=True) + eps)
    return (x32 * inv).astype(x.dtype) * gain


def token_shift(p):
    return jnp.pad(p, ((0, 0), (1, 0), (0, 0)))[:, :-1]


def partial_rope(x, positions):
    half = ROPE_DIM // 2
    inv_freq = ROPE_THETA ** (-jnp.arange(half, dtype=jnp.float32) / half)
    ang = positions.astype(jnp.float32)[..., None] * inv_freq
    cos = jnp.cos(ang)[:, :, None, :]
    sin = jnp.sin(ang)[:, :, None, :]
    xr = x[..., :ROPE_DIM].astype(jnp.float32)
    x1, x2 = xr[..., :half], xr[..., half:]
    rot = jnp.concatenate([x1 * cos - x2 * sin, x2 * cos + x1 * sin], axis=-1).astype(x.dtype)
    return jnp.concatenate([rot, x[..., ROPE_DIM:]], axis=-1)


def wkv7_scan(r, w, k, v, a, b):
    B_, S_, H, N = r.shape

    def step(state, inp):
        r_t, w_t, k_t, v_t, a_t, b_t = inp
        sa = jnp.einsum('bhvk,bhk->bhv', state, a_t)
        state = state * w_t[:, :, None, :] + sa[..., None] * b_t[:, :, None, :] + v_t[..., None] * k_t[:, :, None, :]
        return state, jnp.einsum('bhvk,bhk->bhv', state, r_t)

    xs = tuple(jnp.moveaxis(t.astype(jnp.float32), 1, 0) for t in (r, w, k, v, a, b))
    init = jnp.zeros((B_, H, N, N), jnp.float32)
    _, ys = lax.scan(step, init, xs)
    return jnp.moveaxis(ys, 0, 1)


def rwkv7_time_mix(cols, decay_w0, decay_up, iclr_a0, iclr_up, gate_up, k_k, k_a, r_k, lnx_gain, lnx_bias):
    B_, S_, _ = cols.shape
    W = RWKV_WIDTH
    f32 = jnp.float32
    r = cols[..., :W]
    k = cols[..., W:2 * W]
    v = cols[..., 2 * W:3 * W]
    o = 3 * W
    xw = cols[..., o:o + DECAY_LORA]
    xa = cols[..., o + DECAY_LORA:o + DECAY_LORA + ICLR_LORA]
    xg = cols[..., o + DECAY_LORA + ICLR_LORA:]
    w_log = -jax.nn.softplus(-(decay_w0 + jnp.tanh(xw) @ decay_up).astype(f32)) - 0.5
    decay = jnp.exp(-jnp.exp(w_log))
    a = jax.nn.sigmoid(iclr_a0 + xa @ iclr_up)
    g = jax.nn.sigmoid(xg) @ gate_up
    heads = lambda t: t.reshape(B_, S_, RWKV_HEADS, HEAD_DIM)
    kk = heads(k * k_k).astype(f32)
    kk = kk / jnp.maximum(jnp.sqrt(jnp.sum(kk * kk, axis=-1, keepdims=True)), 1e-12)
    k = k * (1 + (a - 1) * k_a)
    rh, kh, vh = heads(r), heads(k), heads(v)
    ah = heads(a).astype(f32)
    y = wkv7_scan(rh, heads(decay), kh, vh, -kk, kk * ah)
    mu = jnp.mean(y, axis=-1, keepdims=True)
    var = jnp.mean(jnp.square(y - mu), axis=-1, keepdims=True)
    yn = (y - mu) * lax.rsqrt(var + GN_EPS)
    yn = yn * lnx_gain.reshape(RWKV_HEADS, HEAD_DIM).astype(f32) + lnx_bias.reshape(RWKV_HEADS, HEAD_DIM).astype(f32)
    bonus = jnp.sum((rh * kh * r_k).astype(f32), axis=-1, keepdims=True) * vh.astype(f32)
    return (yn + bonus).reshape(B_, S_, W).astype(cols.dtype) * g


def sliding_window_sink_attention(q, k, v, positions, q_norm_gain, k_norm_gain, sinks):
    B_, S_, _ = q.shape
    nblk = S_ // BLOCK
    q = partial_rope(rms_norm(q.reshape(B_, S_, ATTN_Q_HEADS, HEAD_DIM), q_norm_gain), positions)
    k = partial_rope(rms_norm(k.reshape(B_, S_, ATTN_KV_HEADS, HEAD_DIM), k_norm_gain), positions)
    v = v.reshape(B_, S_, ATTN_KV_HEADS, HEAD_DIM)
    qb = q.reshape(B_, nblk, BLOCK, ATTN_KV_HEADS, ATTN_GROUPS, HEAD_DIM)

    def band(t):
        tb = t.reshape(B_, nblk, BLOCK, ATTN_KV_HEADS, HEAD_DIM)
        prev = jnp.pad(tb, ((0, 0), (1, 0), (0, 0), (0, 0), (0, 0)))[:, :-1]
        return jnp.concatenate([prev, tb], axis=2)

    kband, vband = band(k), band(v)
    scores = jnp.einsum('bnqhgd,bnkhd->bnhgqk', qb, kband).astype(jnp.float32) * (HEAD_DIM ** -0.5)
    q_idx = jnp.arange(BLOCK)[:, None]
    k_idx = jnp.arange(2 * BLOCK)[None, :]
    dist = q_idx + BLOCK - k_idx
    in_band = (dist >= 0) & (dist < WINDOW)
    blk = jnp.arange(nblk)[:, None, None]
    valid = in_band[None] & ((blk > 0) | (k_idx >= BLOCK)[None])
    scores = jnp.where(valid[None, :, None, None], scores, NEG_INF)
    sink = sinks.astype(jnp.float32).reshape(ATTN_KV_HEADS, ATTN_GROUPS)[None, None, :, :, None, None]
    m = jnp.maximum(jnp.max(scores, axis=-1, keepdims=True), sink)
    e = jnp.exp(scores - m)
    probs = e / (jnp.sum(e, axis=-1, keepdims=True) + jnp.exp(sink - m))
    out = jnp.einsum('bnhgqk,bnkhd->bnqhgd', probs.astype(v.dtype), vband)
    return out.reshape(B_, S_, ATTN_Q_WIDTH)


def setup_inputs(seed: int = 0) -> dict:
    key = jax.random.key(seed)
    ks = jax.random.split(key, 32)
    f32 = jnp.float32
    nrm = lambda i, shape, s: jax.random.normal(ks[i], shape, f32) * s
    L = DEPTH
    offsets = jax.random.randint(ks[2], (BATCH, 1), 0, 2048, dtype=jnp.int32)
    positions = offsets + jnp.arange(SEQ, dtype=jnp.int32)[None, :]
    return {
        "x": nrm(0, (BATCH, SEQ, D_MODEL), 1.0),
        "c": nrm(1, (BATCH, D_MODEL), 1.0),
        "positions": positions,
        "ada_w": nrm(3, (L, D_MODEL, 6 * D_MODEL), 0.2 * D_MODEL ** -0.5),
        "ada_b": nrm(4, (L, 6 * D_MODEL), 0.01),
        "norm1_gain": 1.0 + nrm(5, (L, D_MODEL), 0.02),
        "norm2_gain": 1.0 + nrm(6, (L, D_MODEL), 0.02),
        "w_in": nrm(7, (L, D_MODEL, IN_WIDTH), D_MODEL ** -0.5),
        "tshift_mu": jax.random.uniform(ks[8], (L, RWKV_SHIFT_WIDTH), f32),
        "decay_w0": jax.random.uniform(ks[9], (L, RWKV_WIDTH), f32, -6.0, 1.0),
        "decay_up": nrm(10, (L, DECAY_LORA, RWKV_WIDTH), 0.5 * DECAY_LORA ** -0.5),
        "iclr_a0": nrm(11, (L, RWKV_WIDTH), 0.5),
        "iclr_up": nrm(12, (L, ICLR_LORA, RWKV_WIDTH), 0.5 * ICLR_LORA ** -0.5),
        "gate_up": nrm(13, (L, GATE_LORA, RWKV_WIDTH), GATE_LORA ** -0.5),
        "k_k": 0.85 + nrm(14, (L, RWKV_WIDTH), 0.05),
        "k_a": 1.0 + nrm(15, (L, RWKV_WIDTH), 0.05),
        "r_k": nrm(16, (L, RWKV_HEADS, HEAD_DIM), 0.1),
        "lnx_gain": 1.0 + nrm(17, (L, RWKV_WIDTH), 0.02),
        "lnx_bias": nrm(18, (L, RWKV_WIDTH), 0.01),
        "q_norm_gain": 1.0 + nrm(19, (L, HEAD_DIM), 0.02),
        "k_norm_gain": 1.0 + nrm(20, (L, HEAD_DIM), 0.02),
        "attn_sinks": nrm(21, (L, ATTN_Q_HEADS), 1.0),
        "branch_gate_b": nrm(22, (L, N_BRANCH * D_MODEL), 0.1),
        "w_branch_a": nrm(23, (L, RWKV_WIDTH, D_MODEL), RWKV_WIDTH ** -0.5),
        "w_branch_b": nrm(24, (L, ATTN_Q_WIDTH, D_MODEL), ATTN_Q_WIDTH ** -0.5),
        "w_out": nrm(25, (L, D_MODEL, D_MODEL), D_MODEL ** -0.5),
        "ffn_w1": nrm(26, (L, D_MODEL, D_FF), D_MODEL ** -0.5),
        "ffn_w3": nrm(27, (L, D_MODEL, D_FF), D_MODEL ** -0.5),
        "ffn_w2": nrm(28, (L, D_FF, D_MODEL), D_FF ** -0.5),
    }


def reference(x, c, positions, ada_w, ada_b, norm1_gain, norm2_gain, w_in, tshift_mu,
              decay_w0, decay_up, iclr_a0, iclr_up, gate_up, k_k, k_a, r_k, lnx_gain, lnx_bias,
              q_norm_gain, k_norm_gain, attn_sinks, branch_gate_b, w_branch_a, w_branch_b, w_out,
              ffn_w1, ffn_w3, ffn_w2):
    q_lo = RWKV_SHIFT_WIDTH
    k_lo = q_lo + ATTN_Q_WIDTH
    v_lo = k_lo + ATTN_KV_WIDTH
    g_lo = v_lo + ATTN_KV_WIDTH
    for l in range(DEPTH):
        ada = (c @ ada_w[l] + ada_b[l])[:, None, :]
        shift1, scale1, gate1, shift2, scale2, gate2 = jnp.split(ada, 6, axis=-1)

        h = rms_norm(x, norm1_gain[l]) * (1 + scale1) + shift1
        proj = jnp.einsum('bsd,de->bse', h, w_in[l])
        rwkv_cols = proj[..., :q_lo]
        rwkv_cols = rwkv_cols + (token_shift(rwkv_cols) - rwkv_cols) * tshift_mu[l]
        y_a = rwkv7_time_mix(rwkv_cols, decay_w0[l], decay_up[l], iclr_a0[l], iclr_up[l], gate_up[l],
                             k_k[l], k_a[l], r_k[l], lnx_gain[l], lnx_bias[l])
        y_b = sliding_window_sink_attention(proj[..., q_lo:k_lo], proj[..., k_lo:v_lo], proj[..., v_lo:g_lo],
                                            positions, q_norm_gain[l], k_norm_gain[l], attn_sinks[l])
        gates = jax.nn.sigmoid(proj[..., g_lo:] + branch_gate_b[l])
        gate_a, gate_b = gates[..., :D_MODEL], gates[..., D_MODEL:]
        merged = gate_a * (y_a @ w_branch_a[l]) + gate_b * (y_b @ w_branch_b[l])
        x = x + gate1 * (merged @ w_out[l])

        h2 = rms_norm(x, norm2_gain[l]) * (1 + scale2) + shift2
        ffn = (jax.nn.silu(h2 @ ffn_w1[l]) * (h2 @ ffn_w3[l])) @ ffn_w2[l]
        x = x + gate2 * ffn
    return x
```

```cpp
#include <hip/hip_runtime.h>
#include <hip/hip_cooperative_groups.h>
#include <cstdio>
#include <cstdint>
namespace cg = cooperative_groups;

namespace pg8 {
#define PG8_LAS __attribute__((address_space(3)))
typedef unsigned short bf16_t;
typedef short bf16x8 __attribute__((ext_vector_type(8)));
typedef float f32x4 __attribute__((ext_vector_type(4)));
typedef unsigned u32x4 __attribute__((ext_vector_type(4)));
constexpr int BM = 256, BK = 64, HALF = 128, HTB = HALF * BK * 2  , STAGE_BYTES = 8 * HTB, NXCD = 8, WGM = 8;

__host__ __device__ __forceinline__ int lds_byte(int r, int c) { const int st = (r >> 4) * 2 + (c >> 5), rr = r & 15, cc = c & 31, ob = rr * 64 + cc * 2; return st * 1024 + (ob ^ (((ob >> 9) & 1) << 5)); }
__host__ __device__ __forceinline__ void stage_rc(int b, int& R, int& C) { const int st = b / 1024, sb = b % 1024, swz = sb ^ (((sb >> 9) & 1) << 5); R = (st >> 1) * 16 + swz / 64; C = (st & 1) * 32 + (swz % 64) / 2; }
__host__ __device__ __forceinline__ int perm32(int rho) { const int n = rho >> 4, i = rho & 15; return 8 * (i >> 2) + 4 * n + (i & 3); }

__device__ __forceinline__ int lane_id_fresh() { int l; asm volatile("v_mbcnt_lo_u32_b32 %0, -1, 0\n\tv_mbcnt_hi_u32_b32 %0, -1, %0" : "=v"(l)); return l; }
struct Unit { int pm, pn; };
struct Gemm { const bf16_t* A; const bf16_t* Bt; int M, N, K, lda; };

struct StaticOrder {
    int nM, nN, nwg, G, c;
    __host__ __device__ void init(int M, int N, int G_, int c_) { nM = M / BM; nN = N / BM; nwg = nM * nN; G = G_; c = c_; }
    __host__ __device__ bool next(int i, Unit& u) const {
        const long L = (long)i * G + c; if (L >= nwg) return false;
        int wgid = (int)L; { const int q = nwg / NXCD, r = nwg % NXCD, xcd = wgid % NXCD, off = wgid / NXCD; wgid = (xcd < r ? xcd * (q + 1) : r * (q + 1) + (xcd - r) * q) + off; }
        const int nig = WGM * nN, gid = wgid / nig, fm = gid * WGM, gsz = (nM - fm) < WGM ? (nM - fm) : WGM;
        u.pm = fm + ((wgid % nig) % gsz); u.pn = (wgid % nig) / gsz; return true;
    }
    __device__ __forceinline__ void a_ready(const Unit&) const {}
    __device__ __forceinline__ void done(const Unit&) const {}
};

__device__ __forceinline__ unsigned cvt_pk_bf16(float lo, float hi) { unsigned r; asm volatile("v_cvt_pk_bf16_f32 %0, %1, %2" : "=v"(r) : "v"(lo), "v"(hi)); return r; }
template <class Epi, class Sched, bool ALIGN_EPI = false, bool SP2 = false>
__device__ __forceinline__ void gemm_phase(PG8_LAS unsigned char* lds, const Gemm g, const Sched& S, const Epi& E, int wave_in) {
    const int wid = wave_in, lane = lane_id_fresh(), tid = wid * 64 + lane, wr = wid >> 2, wc = wid & 3, fr = lane & 15, fq = lane >> 4;
    const int K = g.K, nt = K / BK;
    unsigned voffA[2], voffB[2];
#pragma unroll
    for (int i = 0; i < 2; ++i) { int R, C; stage_rc(tid * 16 + i * 8192, R, C); const int Rb = Epi::PERM ? ((R & ~31) + perm32(R & 31)) : R;
        voffA[i] = (unsigned)(R * g.lda + C) * 2u; voffB[i] = (unsigned)(Rb * K + C) * 2u; }
    const size_t kstep = (size_t)(BK * 2);
    const size_t hstepA = (size_t)HALF * g.lda * 2, hstepB = (size_t)HALF * K * 2;
    const size_t tstepA = 2 * hstepA, tstepB = 2 * hstepB;
    const unsigned ldsw = (unsigned)wid * 1024u;
    const int aoff = lds_byte(wr * 64 + fr, fq * 8), boff = lds_byte(wc * 32 + fr, fq * 8);
#define PG8_SA(b, h) (((b) * 2 + (h)) * HTB)
#define PG8_SB(b, h) ((4 + (b) * 2 + (h)) * HTB)
#define PG8_STAGE(bufoff, gbase, voff) do { _Pragma("unroll") for (int _i = 0; _i < 2; ++_i) \
        __builtin_amdgcn_global_load_lds((const unsigned*)((const char*)(gbase) + (voff)[_i]), (PG8_LAS unsigned*)(lds + (bufoff) + ldsw + _i * 8192), 16, 0, 0); } while (0)
#define PG8_LDA(dst, b, h) do { _Pragma("unroll") for (int m = 0; m < 4; ++m) _Pragma("unroll") for (int k = 0; k < 2; ++k) dst[m][k] = *(const PG8_LAS bf16x8*)(lds + PG8_SA(b, h) + aoff + m * 2048 + k * 1024); } while (0)
#define PG8_LDB(dst, b, h) do { _Pragma("unroll") for (int n = 0; n < 2; ++n) _Pragma("unroll") for (int k = 0; k < 2; ++k) dst[n][k] = *(const PG8_LAS bf16x8*)(lds + PG8_SB(b, h) + boff + n * 2048 + k * 1024); } while (0)
#define PG8_MMA(ai, bj, At, Bt) do { __builtin_amdgcn_s_setprio(1); _Pragma("unroll") for (int m = 0; m < 4; ++m) _Pragma("unroll") for (int n = 0; n < 2; ++n) _Pragma("unroll") for (int k = 0; k < 2; ++k) \
        acc[ai][bj][m][n] = __builtin_amdgcn_mfma_f32_16x16x32_bf16(Bt[n][k], At[m][k], acc[ai][bj][m][n], 0, 0, 0); __builtin_amdgcn_s_setprio(0); } while (0)
#define PG8_WAIT_V(n) asm volatile("s_waitcnt vmcnt(" #n ")" ::: "memory")
#define PG8_WAIT_L(n) asm volatile("s_waitcnt lgkmcnt(" #n ")" ::: "memory")
#define PG8_BAR __builtin_amdgcn_s_barrier()
#define PG8_SCHED __builtin_amdgcn_sched_barrier(0)
    Unit cur, nxt; int ui = 0;
    if (!S.next(0, cur)) return;
    f32x4 acc[2][2][4][2];
#pragma unroll
    for (int a = 0; a < 2; ++a)
#pragma unroll
        for (int b = 0; b < 2; ++b)
#pragma unroll
            for (int m = 0; m < 4; ++m)
#pragma unroll
                for (int n = 0; n < 2; ++n) acc[a][b][m][n] = (f32x4){0.f, 0.f, 0.f, 0.f};
    bf16x8 At[4][2], B0[2][2], B1[2][2];
    const char* cA = (const char*)g.A + (size_t)cur.pm * tstepA; const char* cB = (const char*)g.Bt + (size_t)cur.pn * tstepB;
    S.a_ready(cur);
    if constexpr (SP2) {
        PG8_STAGE(PG8_SB(0, 0), cB, voffB); PG8_STAGE(PG8_SB(0, 1), cB + hstepB, voffB); PG8_STAGE(PG8_SA(0, 0), cA, voffA); PG8_STAGE(PG8_SA(0, 1), cA + hstepA, voffA);
        if (wr == 1) PG8_BAR;
        PG8_WAIT_V(2); PG8_BAR;
        PG8_STAGE(PG8_SB(1, 0), cB + kstep, voffB); PG8_STAGE(PG8_SA(1, 0), cA + kstep, voffA); PG8_STAGE(PG8_SB(1, 1), cB + hstepB + kstep, voffB);
        PG8_WAIT_V(6); PG8_BAR;
    } else {
        PG8_STAGE(PG8_SB(0, 0), cB, voffB); PG8_STAGE(PG8_SA(0, 0), cA, voffA); PG8_STAGE(PG8_SB(0, 1), cB + hstepB, voffB); PG8_STAGE(PG8_SA(0, 1), cA + hstepA, voffA);
        if (wr == 1) PG8_BAR;
        PG8_WAIT_V(4); PG8_BAR;
        PG8_STAGE(PG8_SB(1, 0), cB + kstep, voffB); PG8_STAGE(PG8_SA(1, 0), cA + kstep, voffA); PG8_STAGE(PG8_SB(1, 1), cB + hstepB + kstep, voffB);
        PG8_WAIT_V(6); PG8_BAR;
    }
    for (;;) {
        const bool has_next = S.next(ui + 1, nxt);
        const char* nA = has_next ? (const char*)g.A + (size_t)nxt.pm * tstepA : cA; const char* nB = has_next ? (const char*)g.Bt + (size_t)nxt.pn * tstepB : cB;
        for (int t = 0; t < nt; t += 2) {
            const bool last = (t == nt - 2);
            const char* a1 = cA + (size_t)(t + 1) * kstep;
            const char* a2 = last ? nA : cA + (size_t)(t + 2) * kstep; const char* b2 = last ? nB : cB + (size_t)(t + 2) * kstep;
            const char* a3 = a2 + kstep; const char* b3 = b2 + kstep;
            if (last && has_next) S.a_ready(nxt);
            if constexpr (SP2) {
            PG8_LDB(B0, 0, 0); PG8_LDB(B1, 0, 1); PG8_SCHED; PG8_LDA(At, 0, 0); PG8_STAGE(PG8_SA(1, 1), a1 + hstepA, voffA);
            PG8_WAIT_V(8); PG8_WAIT_L(0); PG8_BAR; PG8_MMA(0, 0, At, B0); PG8_MMA(0, 1, At, B1); PG8_BAR; PG8_SCHED;
            PG8_LDA(At, 0, 1); PG8_STAGE(PG8_SB(0, 0), b2, voffB); PG8_STAGE(PG8_SB(0, 1), b2 + hstepB, voffB); PG8_STAGE(PG8_SA(0, 0), a2, voffA);
            PG8_WAIT_V(8); PG8_WAIT_L(0); PG8_BAR; PG8_MMA(1, 0, At, B0); PG8_MMA(1, 1, At, B1); PG8_BAR; PG8_SCHED;
            PG8_LDB(B0, 1, 0); PG8_LDB(B1, 1, 1); PG8_SCHED; PG8_LDA(At, 1, 0); PG8_STAGE(PG8_SA(0, 1), a2 + hstepA, voffA);
            PG8_WAIT_V(8); PG8_WAIT_L(0); PG8_BAR; PG8_MMA(0, 0, At, B0); PG8_MMA(0, 1, At, B1); PG8_BAR; PG8_SCHED;
            PG8_LDA(At, 1, 1); PG8_STAGE(PG8_SB(1, 0), b3, voffB); PG8_STAGE(PG8_SB(1, 1), b3 + hstepB, voffB); PG8_STAGE(PG8_SA(1, 0), a3, voffA);
            PG8_WAIT_V(8); PG8_WAIT_L(0); PG8_BAR; PG8_MMA(1, 0, At, B0); PG8_MMA(1, 1, At, B1); PG8_BAR; PG8_SCHED;
            } else {
            PG8_LDB(B0, 0, 0); PG8_SCHED; PG8_LDA(At, 0, 0); PG8_STAGE(PG8_SA(1, 1), a1 + hstepA, voffA);
            PG8_WAIT_L(8); PG8_BAR; PG8_WAIT_L(0); PG8_MMA(0, 0, At, B0); PG8_BAR; PG8_SCHED;
            PG8_LDB(B1, 0, 1); PG8_STAGE(PG8_SB(0, 0), b2, voffB);
            PG8_BAR; PG8_WAIT_L(0); PG8_MMA(0, 1, At, B1); PG8_BAR;
            PG8_LDA(At, 0, 1); PG8_STAGE(PG8_SA(0, 0), a2, voffA);
            PG8_BAR; PG8_WAIT_L(0); PG8_MMA(1, 0, At, B0); PG8_BAR; PG8_SCHED;
            PG8_STAGE(PG8_SB(0, 1), b2 + hstepB, voffB);
            PG8_WAIT_V(6); PG8_BAR; PG8_MMA(1, 1, At, B1); PG8_BAR;
            PG8_LDB(B0, 1, 0); PG8_SCHED; PG8_LDA(At, 1, 0); PG8_STAGE(PG8_SA(0, 1), a2 + hstepA, voffA);
            PG8_WAIT_L(8); PG8_BAR; PG8_WAIT_L(0); PG8_MMA(0, 0, At, B0); PG8_BAR; PG8_SCHED;
            PG8_LDB(B1, 1, 1); PG8_STAGE(PG8_SB(1, 0), b3, voffB);
            PG8_BAR; PG8_WAIT_L(0); PG8_MMA(0, 1, At, B1); PG8_BAR;
            PG8_LDA(At, 1, 1); PG8_STAGE(PG8_SA(1, 0), a3, voffA);
            PG8_BAR; PG8_WAIT_L(0); PG8_MMA(1, 0, At, B0); PG8_BAR; PG8_SCHED;
            PG8_STAGE(PG8_SB(1, 1), b3 + hstepB, voffB);
            PG8_WAIT_V(6); PG8_BAR; PG8_MMA(1, 1, At, B1); PG8_BAR;
            }
        }
        if constexpr (ALIGN_EPI) { if (wr == 0) PG8_BAR; }
        if constexpr (!Epi::AFTER_DRAIN) { E(acc, cur, wr, wc, fr, fq); S.done(cur); }
        if (!has_next) break;
#pragma unroll
        for (int a = 0; a < 2; ++a)
#pragma unroll
            for (int b = 0; b < 2; ++b)
#pragma unroll
                for (int m = 0; m < 4; ++m)
#pragma unroll
                    for (int n = 0; n < 2; ++n) acc[a][b][m][n] = (f32x4){0.f, 0.f, 0.f, 0.f};
        cur = nxt; cA = nA; cB = nB; ++ui;
        if constexpr (ALIGN_EPI) { if (wr == 1) PG8_BAR; }
    }
    PG8_WAIT_V(0);
    if constexpr (!ALIGN_EPI) { if (wr == 0) PG8_BAR; }
    PG8_BAR;
    if constexpr (Epi::AFTER_DRAIN) { E.fused(acc, cur, wr, wc, fr, fq, lds, wid, lane); S.done(cur); }
#undef PG8_SA
#undef PG8_SB
#undef PG8_STAGE
#undef PG8_LDA
#undef PG8_LDB
#undef PG8_MMA
#undef PG8_WAIT_V
#undef PG8_WAIT_L
#undef PG8_BAR
#undef PG8_SCHED
}
}

#define LAS __attribute__((address_space(3)))
typedef unsigned short bf16;
typedef short bf16x8 __attribute__((ext_vector_type(8)));
typedef float f32x4 __attribute__((ext_vector_type(4)));
typedef unsigned u32x4 __attribute__((ext_vector_type(4)));
typedef unsigned u32x2 __attribute__((ext_vector_type(2)));

constexpr int BATCH = 8, SEQ = 4096, T = BATCH * SEQ, D = 1024, INW = 4608, RW = 1792, QW = 2816, FF = 2816, ADAW = 6144;
constexpr int QC_Q = 0, QC_K = 512, QC_V = 640, QC_GA = 768, QC_GB = 1792;
constexpr size_t MiB = 1u << 20;
constexpr size_t WS_WIN = 1 * MiB, WS_WA = 10 * MiB, WS_WB = 11 * MiB, WS_WOUT = 12 * MiB, WS_W13 = 14 * MiB, WS_W2 = 25 * MiB;
constexpr size_t WS_DUT = 31 * MiB, WS_IUT = WS_DUT + 65536, WS_GUT = WS_IUT + 65536;
constexpr size_t WS_ADAP = 32 * MiB, WS_ADA = 35 * MiB, WS_RK = 36 * MiB;
constexpr size_t WS_HBUF = 40 * MiB, WS_QKVG = 104 * MiB, WS_R = 280 * MiB, WS_K = 312 * MiB, WS_V = 344 * MiB, WS_LW = 376 * MiB, WS_YA = 376 * MiB  , WS_MC = 408 * MiB  , WS_PG = 440 * MiB, WS_YB = 472 * MiB, WS_ROPE = 504 * MiB  , WS_SLOT = 506 * MiB  , WS_END = 508 * MiB;
constexpr size_t DO_QG = 0, DO_Y0 = 64 * MiB, DO_RP = 96 * MiB;
constexpr int LDS_BYTES = 147456;
constexpr int KSPLIT = 16;

__device__ __forceinline__ float bf2f(bf16 v) { return __uint_as_float((unsigned)v << 16); }
typedef float f32x2_t __attribute__((ext_vector_type(2))); typedef __bf16 bf16x2_t __attribute__((ext_vector_type(2)));
__device__ __forceinline__ unsigned pk2(float lo, float hi) { f32x2_t v = {lo, hi}; bf16x2_t b = __builtin_convertvector(v, bf16x2_t); return __builtin_bit_cast(unsigned, b); }
__device__ __forceinline__ unsigned f2bf(float f) { return pk2(f, f) & 0xffffu; }
__device__ __forceinline__ float sigmoidf_(float x) { return __builtin_amdgcn_rcpf(1.0f + __expf(-x)); }
template <int CTRL, int ROWMASK> __device__ __forceinline__ float dpp_perm(float v) {
    return __int_as_float(__builtin_amdgcn_update_dpp(0, __float_as_int(v), CTRL, ROWMASK, 0xF, false));
}
__device__ __forceinline__ float wave_sum(float v) {
    v += dpp_perm<0xB1, 0xF>(v);
    v += dpp_perm<0x4E, 0xF>(v);
    v += dpp_perm<0x141, 0xF>(v);
    v += dpp_perm<0x140, 0xF>(v);
    v += dpp_perm<0x142, 0xA>(v);
    v += dpp_perm<0x143, 0xC>(v);
    return __int_as_float(__builtin_amdgcn_readlane(__float_as_int(v), 63));
}
__device__ __forceinline__ float row16_sum(float v) { v += dpp_perm<0xB1, 0xF>(v); v += dpp_perm<0x4E, 0xF>(v); v += dpp_perm<0x141, 0xF>(v); v += dpp_perm<0x140, 0xF>(v); return v; }
__device__ __forceinline__ float row16_max(float v) { v = fmaxf(v, dpp_perm<0xB1, 0xF>(v)); v = fmaxf(v, dpp_perm<0x4E, 0xF>(v)); v = fmaxf(v, dpp_perm<0x141, 0xF>(v)); v = fmaxf(v, dpp_perm<0x140, 0xF>(v)); return v; }
__device__ __forceinline__ float rows4_sum(float v) {
    { auto r = __builtin_amdgcn_permlane32_swap(__float_as_uint(v), __float_as_uint(v), false, false); v = __uint_as_float(r[0]) + __uint_as_float(r[1]); }
    { auto r = __builtin_amdgcn_permlane16_swap(__float_as_uint(v), __float_as_uint(v), false, false); v = __uint_as_float(r[0]) + __uint_as_float(r[1]); }
    return v;
}
#define LDS_WAIT() asm volatile("s_waitcnt lgkmcnt(0)" ::: "memory")
#define LBAR() do { asm volatile("s_waitcnt lgkmcnt(0)" ::: "memory"); __builtin_amdgcn_s_barrier(); asm volatile("" ::: "memory"); } while (0)
__device__ __forceinline__ f32x4 bf4(u32x2 w) { return (f32x4){__uint_as_float(w.x << 16), __uint_as_float(w.x & 0xffff0000u), __uint_as_float(w.y << 16), __uint_as_float(w.y & 0xffff0000u)}; }

using pg8::Unit;
using pg8::cvt_pk_bf16;
constexpr int HALF = 128;

struct EpiProj {
    static constexpr bool PERM = true, AFTER_DRAIN = false;
    bf16* Rb; bf16* Q; const float* gbias;
    __device__ __forceinline__ void operator()(const f32x4 (&acc)[2][2][4][2], const Unit& u, int wr, int wc, int fr, int fq) const {
        const int row0 = u.pm * 256 + wr * 64 + fr; const int colt = u.pn * 256;
        bf16* base; int ldc, c0;
        if (u.pn < 7) { base = Rb; ldc = RW; c0 = colt; } else { base = Q; ldc = QW; c0 = colt - RW; }
        const bool gate = u.pn >= 10;
        const int col0 = c0 + wc * 32 + 8 * fq;
#pragma unroll
        for (int bj = 0; bj < 2; ++bj) {
            f32x4 b0 = (f32x4){0.f, 0.f, 0.f, 0.f}, b1 = b0;
            if (gate) { const float* gp = gbias + (colt - 2560) + bj * HALF + wc * 32 + 8 * fq; b0 = *(const f32x4*)gp; b1 = *(const f32x4*)(gp + 4); }
#pragma unroll
            for (int ai = 0; ai < 2; ++ai)
#pragma unroll
                for (int m = 0; m < 4; ++m) {
                    f32x4 v0 = acc[ai][bj][m][0], v1 = acc[ai][bj][m][1];
                    if (gate) {
                        v0 += b0; v1 += b1;
#pragma unroll
                        for (int i = 0; i < 4; ++i) { v0[i] = sigmoidf_(v0[i]); v1[i] = sigmoidf_(v1[i]); }
                    }
                    u32x4 w; w.x = cvt_pk_bf16(v0[0], v0[1]); w.y = cvt_pk_bf16(v0[2], v0[3]); w.z = cvt_pk_bf16(v1[0], v1[1]); w.w = cvt_pk_bf16(v1[2], v1[3]);
                    *(u32x4*)(base + (size_t)(row0 + ai * HALF + m * 16) * ldc + col0 + bj * HALF) = w;
                }
        }
    }
};

__device__ __forceinline__ void bf8(u32x4 w, f32x4& lo, f32x4& hi) {
    lo = (f32x4){__uint_as_float(w.x << 16), __uint_as_float(w.x & 0xffff0000u), __uint_as_float(w.y << 16), __uint_as_float(w.y & 0xffff0000u)};
    hi = (f32x4){__uint_as_float(w.z << 16), __uint_as_float(w.z & 0xffff0000u), __uint_as_float(w.w << 16), __uint_as_float(w.w & 0xffff0000u)};
}
template <int MODE> struct EpiBranch {
    static constexpr bool PERM = true, AFTER_DRAIN = false;
    const bf16* Q; float* tmp; bf16* merged;
    __device__ __forceinline__ void operator()(const f32x4 (&acc)[2][2][4][2], const Unit& u, int wr, int wc, int fr, int fq) const {
        const int row0 = u.pm * 256 + wr * 64 + fr; const int col0 = u.pn * 256 + wc * 32 + 8 * fq;
#pragma unroll
        for (int ai = 0; ai < 2; ++ai)
#pragma unroll
            for (int m = 0; m < 4; ++m) {
                const size_t row = (size_t)(row0 + ai * HALF + m * 16);
#pragma unroll
                for (int bj = 0; bj < 2; ++bj) {
                    const int col = col0 + bj * HALF;
                    f32x4 g0, g1; bf8(*(const u32x4*)(Q + row * QW + (MODE == 0 ? QC_GA : QC_GB) + col), g0, g1);
                    f32x4 v0 = acc[ai][bj][m][0] * g0, v1 = acc[ai][bj][m][1] * g1;
                    if (MODE == 1) { f32x4 t0, t1; bf8(*(const u32x4*)(merged + row * D + col), t0, t1); v0 += t0; v1 += t1; }
                    u32x4 w; w.x = cvt_pk_bf16(v0[0], v0[1]); w.y = cvt_pk_bf16(v0[2], v0[3]); w.z = cvt_pk_bf16(v1[0], v1[1]); w.w = cvt_pk_bf16(v1[2], v1[3]);
                    *(u32x4*)(merged + row * D + col) = w;
                }
            }
    }
};

struct EpiRes {
    static constexpr bool PERM = false, AFTER_DRAIN = false;
    const float* base; float* out; const float* gate;
    __device__ __forceinline__ void operator()(const f32x4 (&acc)[2][2][4][2], const Unit& u, int wr, int wc, int fr, int fq) const {
        const int row0 = u.pm * 256 + wr * 64 + fr; const int col0 = u.pn * 256 + wc * 32 + 4 * fq;
        const float* gp = gate + (size_t)(u.pm / 16) * ADAW;
#pragma unroll
        for (int bj = 0; bj < 2; ++bj)
#pragma unroll
            for (int n = 0; n < 2; ++n) {
                const int col = col0 + bj * HALF + n * 16;
                const f32x4 g = *(const f32x4*)(gp + col);
#pragma unroll
                for (int ai = 0; ai < 2; ++ai)
#pragma unroll
                    for (int m = 0; m < 4; ++m) {
                        const size_t off = (size_t)(row0 + ai * HALF + m * 16) * D + col;
                        *(f32x4*)(out + off) = *(const f32x4*)(base + off) + g * acc[ai][bj][m][n];
                    }
            }
    }
};


struct EpiResNorm {
    static constexpr bool PERM = true, AFTER_DRAIN = false;
    const float* base; float* out; const float* gate; const float* ada; const float* g2; float* slots; unsigned* cnt; bf16* H2;
    __device__ __forceinline__ void operator()(f32x4 (&acc)[2][2][4][2], const Unit& u, int wr, int wc, int fr, int fq) const {
        const int row0 = u.pm * 256 + wr * 64 + fr; const int col0 = u.pn * 256 + wc * 32 + 8 * fq;
        const int b = u.pm / 16;
#pragma unroll
        for (int bj = 0; bj < 2; ++bj) {
            const int col = col0 + bj * HALF;
            const f32x4 g0 = *(const f32x4*)(gate + (size_t)b * ADAW + col), g1 = *(const f32x4*)(gate + (size_t)b * ADAW + col + 4);
#pragma unroll
            for (int ai = 0; ai < 2; ++ai)
#pragma unroll
                for (int m = 0; m < 4; ++m) {
                    const size_t off = (size_t)(row0 + ai * HALF + m * 16) * D + col;
                    const f32x4 x0 = *(const f32x4*)(base + off) + g0 * acc[ai][bj][m][0], x1 = *(const f32x4*)(base + off + 4) + g1 * acc[ai][bj][m][1];
                    *(f32x4*)(out + off) = x0; *(f32x4*)(out + off + 4) = x1;
                    acc[ai][bj][m][0] = x0; acc[ai][bj][m][1] = x1;
                }
        }
#pragma unroll
        for (int ai = 0; ai < 2; ++ai)
#pragma unroll
            for (int m = 0; m < 4; ++m) {
                float s = 0.f;
#pragma unroll
                for (int bj = 0; bj < 2; ++bj)
#pragma unroll
                    for (int n = 0; n < 2; ++n) { const f32x4 v = acc[ai][bj][m][n]; s += (v[0] * v[0] + v[1] * v[1]) + (v[2] * v[2] + v[3] * v[3]); }
                s = rows4_sum(s);
                if (fq == 0) __hip_atomic_store(slots + (size_t)(row0 + ai * HALF + m * 16) * 16 + u.pn * 4 + wc, s, __ATOMIC_RELAXED, __HIP_MEMORY_SCOPE_AGENT);
            }
        asm volatile("s_waitcnt vmcnt(0)" ::: "memory");
        unsigned* c = cnt + 16 * u.pm;
        if ((fr | fq) == 0) __hip_atomic_fetch_add(c, 1u, __ATOMIC_RELAXED, __HIP_MEMORY_SCOPE_AGENT);
        for (unsigned sp = 0; sp < (1u << 22); ++sp) {
            if ((unsigned)__builtin_amdgcn_readfirstlane((int)__hip_atomic_load(c, __ATOMIC_RELAXED, __HIP_MEMORY_SCOPE_AGENT)) >= 32u) break;
            __builtin_amdgcn_s_sleep(2);
        }
        __builtin_amdgcn_fence(__ATOMIC_ACQUIRE, "agent");
        f32x4 sc[2][2], sh[2][2];
#pragma unroll
        for (int bj = 0; bj < 2; ++bj)
#pragma unroll
            for (int n = 0; n < 2; ++n) {
                const int col = col0 + bj * HALF + n * 4;
                sc[bj][n] = *(const f32x4*)(g2 + col) * (*(const f32x4*)(ada + (size_t)b * ADAW + 4096 + col) + 1.0f);
                sh[bj][n] = *(const f32x4*)(ada + (size_t)b * ADAW + 3072 + col);
            }
#pragma unroll
        for (int ai = 0; ai < 2; ++ai)
#pragma unroll
            for (int m = 0; m < 4; ++m) {
                const size_t row = (size_t)(row0 + ai * HALF + m * 16);
                const unsigned long long* sl = (const unsigned long long*)(slots + row * 16 + fq * 4);
                const unsigned long long w0 = __hip_atomic_load(sl, __ATOMIC_RELAXED, __HIP_MEMORY_SCOPE_AGENT), w1 = __hip_atomic_load(sl + 1, __ATOMIC_RELAXED, __HIP_MEMORY_SCOPE_AGENT);
                float t = (__uint_as_float((unsigned)w0) + __uint_as_float((unsigned)(w0 >> 32))) + (__uint_as_float((unsigned)w1) + __uint_as_float((unsigned)(w1 >> 32)));
                t = rows4_sum(t);
                const float inv = rsqrtf(t * (1.0f / D) + 1e-6f);
#pragma unroll
                for (int bj = 0; bj < 2; ++bj) {
                    const f32x4 o0 = acc[ai][bj][m][0] * inv * sc[bj][0] + sh[bj][0], o1 = acc[ai][bj][m][1] * inv * sc[bj][1] + sh[bj][1];
                    u32x4 w; w.x = cvt_pk_bf16(o0[0], o0[1]); w.y = cvt_pk_bf16(o0[2], o0[3]); w.z = cvt_pk_bf16(o1[0], o1[1]); w.w = cvt_pk_bf16(o1[2], o1[3]);
                    *(u32x4*)(H2 + row * D + col0 + bj * HALF) = w;
                }
            }
    }
};

struct EpiSwiglu {
    static constexpr bool PERM = true, AFTER_DRAIN = false;
    bf16* H;
    __device__ __forceinline__ void operator()(const f32x4 (&acc)[2][2][4][2], const Unit& u, int wr, int wc, int fr, int fq) const {
        const int row0 = u.pm * 256 + wr * 64 + fr; const int col0 = u.pn * 128 + wc * 32 + 8 * fq;
#pragma unroll
        for (int ai = 0; ai < 2; ++ai)
#pragma unroll
            for (int m = 0; m < 4; ++m) {
                float o[8];
#pragma unroll
                for (int n = 0; n < 2; ++n)
#pragma unroll
                    for (int i = 0; i < 4; ++i) { const float a = acc[ai][0][m][n][i], b = acc[ai][1][m][n][i]; o[n * 4 + i] = a * sigmoidf_(a) * b; }
                u32x4 w; w.x = cvt_pk_bf16(o[0], o[1]); w.y = cvt_pk_bf16(o[2], o[3]); w.z = cvt_pk_bf16(o[4], o[5]); w.w = cvt_pk_bf16(o[6], o[7]);
                *(u32x4*)(H + (size_t)(row0 + ai * HALF + m * 16) * FF + col0) = w;
            }
    }
};

__device__ __forceinline__ void transpose_item(const float* __restrict__ W, int K, int N, bf16* WT, int mode, LAS float* scr, int item, int lane) {
    const int nblk = N / 32, kb = item / nblk, nb = item % nblk, k0 = 64 * kb, n0 = 32 * nb;
#pragma unroll 8
    for (int i = 0; i < 32; ++i) { const int kk = 2 * i + (lane >> 5); scr[kk * 33 + (lane & 31)] = W[(size_t)(k0 + kk) * N + n0 + (lane & 31)]; }
    LDS_WAIT();
    const int c = lane & 7;
#pragma unroll
    for (int j = 0; j < 4; ++j) {
        const int nn = (lane >> 3) + 8 * j; const LAS float* s = scr + (8 * c) * 33 + nn;
        u32x4 o; o.x = pk2(s[0 * 33], s[1 * 33]); o.y = pk2(s[2 * 33], s[3 * 33]); o.z = pk2(s[4 * 33], s[5 * 33]); o.w = pk2(s[6 * 33], s[7 * 33]);
        const int n = n0 + nn; const int drow = (mode == 0) ? n : ((n >> 7) * 256 + (mode == 2 ? 128 : 0) + (n & 127));
        *(u32x4*)(WT + (size_t)drow * K + k0 + 8 * c) = o;
    }
    LDS_WAIT();
}

struct P0Args { const float *w_in, *wa, *wb, *wout, *w1, *w3, *w2, *ada_w, *c, *decay_up, *iclr_up, *gate_up; unsigned char* ws; };

__device__ __forceinline__ void phase0(const P0Args& A, LAS unsigned char* lds, int gw, int NGW, int wave, int lane, int gt, int NGT) {
    LAS float* scr = (LAS float*)(lds + wave * 16384);
    constexpr int I_IN = 16 * 144, I_A = 8 * 32, I_O = 16 * 32, I_1 = 16 * 88, I_2 = 44 * 32, I_ADA = KSPLIT * 96;
    constexpr int NITEMS = I_IN + 2 * I_A + I_O + 2 * I_1 + I_2 + I_ADA;
    for (int it = gw; it < NITEMS; it += NGW) {
        int r = it;
        if (r < I_ADA) {
            const int ks = r / 96, cb = r % 96, col = cb * 64 + lane;
            float acc[8];
#pragma unroll
            for (int b = 0; b < 8; ++b) acc[b] = 0.f;
            for (int kk = 0; kk < 64; ++kk) {
                const int k = ks * 64 + kk; const float w = A.ada_w[(size_t)k * ADAW + col];
#pragma unroll
                for (int b = 0; b < 8; ++b) acc[b] += A.c[b * D + k] * w;
            }
            float* adap = (float*)(A.ws + WS_ADAP);
#pragma unroll
            for (int b = 0; b < 8; ++b) adap[(size_t)(ks * 8 + b) * ADAW + col] = acc[b];
            continue;
        }
        r -= I_ADA;
        if (r < I_IN) { transpose_item(A.w_in, D, INW, (bf16*)(A.ws + WS_WIN), 0, scr, r, lane); continue; } r -= I_IN;
        if (r < I_A) { transpose_item(A.wa, 512, D, (bf16*)(A.ws + WS_WA), 0, scr, r, lane); continue; } r -= I_A;
        if (r < I_A) { transpose_item(A.wb, 512, D, (bf16*)(A.ws + WS_WB), 0, scr, r, lane); continue; } r -= I_A;
        if (r < I_O) { transpose_item(A.wout, D, D, (bf16*)(A.ws + WS_WOUT), 0, scr, r, lane); continue; } r -= I_O;
        if (r < I_1) { transpose_item(A.w1, D, FF, (bf16*)(A.ws + WS_W13), 1, scr, r, lane); continue; } r -= I_1;
        if (r < I_1) { transpose_item(A.w3, D, FF, (bf16*)(A.ws + WS_W13), 2, scr, r, lane); continue; } r -= I_1;
        transpose_item(A.w2, FF, D, (bf16*)(A.ws + WS_W2), 0, scr, r, lane);
    }
    bf16* DUT = (bf16*)(A.ws + WS_DUT); bf16* IUT = (bf16*)(A.ws + WS_IUT); bf16* GUT = (bf16*)(A.ws + WS_GUT);
    for (int i = gt; i < 512 * 64; i += NGT) { const int ch = i >> 6, k = i & 63; const int d = ((((ch >> 4) * 2 + (k >> 5)) * 64 + ((k >> 3) & 3) * 16 + (ch & 15)) * 8 + (k & 7));
        DUT[d] = (bf16)f2bf(A.decay_up[k * 512 + ch]); IUT[d] = (bf16)f2bf(A.iclr_up[k * 512 + ch]); }
    for (int i = gt; i < 512 * 128; i += NGT) { const int ch = i >> 7, k = i & 127; const int d = ((((ch >> 4) * 4 + (k >> 5)) * 64 + ((k >> 3) & 3) * 16 + (ch & 15)) * 8 + (k & 7));
        GUT[d] = (bf16)f2bf(A.gate_up[k * 512 + ch]); }
}

template <bool PARTIALS>
__device__ __forceinline__ void norm_mod_phase(const float* X, const float* __restrict__ gain, const float* __restrict__ ada_b, const unsigned char* ws, int shift_off, int scale_off, bf16* H, int gw, int NGW, int lane) {
    const float* adap = (const float*)(ws + WS_ADAP); const float* ada = (const float*)(ws + WS_ADA);
    for (int blk = gw; blk < T / 16; blk += NGW) {
        const int r0 = blk * 16, b = r0 / SEQ;
        f32x4 sc[4], sh[4];
#pragma unroll
        for (int j = 0; j < 4; ++j) {
            const int c = 4 * lane + 256 * j;
            f32x4 s, h;
            if (PARTIALS) {
                s = *(const f32x4*)(ada_b + scale_off + c); h = *(const f32x4*)(ada_b + shift_off + c);
                for (int ks = 0; ks < KSPLIT; ++ks) { const float* p = adap + (size_t)(ks * 8 + b) * ADAW; s += *(const f32x4*)(p + scale_off + c); h += *(const f32x4*)(p + shift_off + c); }
            } else { s = *(const f32x4*)(ada + (size_t)b * ADAW + scale_off + c); h = *(const f32x4*)(ada + (size_t)b * ADAW + shift_off + c); }
            const f32x4 g = *(const f32x4*)(gain + c);
            sc[j] = g * (s + 1.0f); sh[j] = h;
        }
        f32x4 nv[4];
        { const f32x4* xr = (const f32x4*)(X + (size_t)r0 * D) + lane;
#pragma unroll
          for (int j = 0; j < 4; ++j) nv[j] = xr[64 * j]; }
        for (int rr = 0; rr < 16; ++rr) {
            const size_t row = (size_t)(r0 + rr);
            f32x4 v[4]; float ss = 0.f;
#pragma unroll
            for (int j = 0; j < 4; ++j) { v[j] = nv[j]; ss += (v[j].x * v[j].x + v[j].y * v[j].y) + (v[j].z * v[j].z + v[j].w * v[j].w); }
            { const f32x4* xr = (const f32x4*)(X + (size_t)(r0 + ((rr < 15) ? rr + 1 : 15)) * D) + lane;
#pragma unroll
              for (int j = 0; j < 4; ++j) nv[j] = xr[64 * j]; }
            const float inv = rsqrtf(wave_sum(ss) * (1.0f / D) + 1e-6f);
            unsigned long long* o8 = (unsigned long long*)(H + row * D) + lane;
#pragma unroll
            for (int j = 0; j < 4; ++j) {
                const f32x4 o = v[j] * inv * sc[j] + sh[j];
                o8[64 * j] = (unsigned long long)pk2(o.x, o.y) | ((unsigned long long)pk2(o.z, o.w) << 32);
            }
        }
    }
}

#ifndef REP_P3A
#define REP_P3A 1
#endif
struct P3Args { const bf16* Rb; const float *mu, *w0, *a0, *k_a, *r_k; unsigned char* ws; };

__device__ __forceinline__ void phase3(const P3Args& A, unsigned char* lds, int tid, int wave, int lane) {
    constexpr int AST = 264;
    bf16* ACT = (bf16*)lds;
    const bf16* DUT = (const bf16*)(A.ws + WS_DUT); const bf16* IUT = (const bf16*)(A.ws + WS_IUT); const bf16* GUT = (const bf16*)(A.ws + WS_GUT);
    bf16* Rr = (bf16*)(A.ws + WS_R); bf16* Kr = (bf16*)(A.ws + WS_K); bf16* Vr = (bf16*)(A.ws + WS_V);
    bf16* G = (bf16*)(A.ws + WS_HBUF); bf16* AH = (bf16*)(A.ws + WS_HBUF + 32 * MiB);
    float* LW = (float*)(A.ws + WS_LW); float* RK = (float*)(A.ws + WS_RK);
    const int fr0 = lane & 15, fq0 = lane >> 4;
    for (int blk = blockIdx.x; blk < T / 128; blk += gridDim.x) {
        const int t0 = blk * 128, b = t0 / SEQ, s0 = t0 % SEQ;
        __syncthreads();
#pragma unroll 1
        for (int rep = 0; rep < 8 * REP_P3A; ++rep) {
            const int task = tid + (rep & 7) * 512, tok = task >> 5, c8 = (task & 31) * 8, t = t0 + tok;
            const u32x4 pc = *(const u32x4*)(A.Rb + (size_t)t * RW + 1536 + c8);
            u32x4 pp = (u32x4){0u, 0u, 0u, 0u};
            if (t % SEQ) pp = *(const u32x4*)(A.Rb + (size_t)(t - 1) * RW + 1536 + c8);
            const f32x4 m0 = *(const f32x4*)(A.mu + 1536 + c8), m1 = *(const f32x4*)(A.mu + 1536 + c8 + 4);
            const unsigned pcw[4] = {pc.x, pc.y, pc.z, pc.w}, ppw[4] = {pp.x, pp.y, pp.z, pp.w};
            float x[8];
#pragma unroll
            for (int i = 0; i < 4; ++i) {
                const float c_lo = __uint_as_float(pcw[i] << 16), c_hi = __uint_as_float(pcw[i] & 0xffff0000u), p_lo = __uint_as_float(ppw[i] << 16), p_hi = __uint_as_float(ppw[i] & 0xffff0000u);
                const float mlo = (i < 2) ? m0[2 * i] : m1[2 * i - 4], mhi = (i < 2) ? m0[2 * i + 1] : m1[2 * i - 3];
                x[2 * i] = c_lo + (p_lo - c_lo) * mlo; x[2 * i + 1] = c_hi + (p_hi - c_hi) * mhi;
            }
            if (c8 < 64) {
#pragma unroll
                for (int i = 0; i < 8; ++i) { const float e = __expf(-2.0f * fabsf(x[i])); const float th = (1.0f - e) * __builtin_amdgcn_rcpf(1.0f + e); x[i] = copysignf(th, x[i]); }
            } else if (c8 >= 128) {
#pragma unroll
                for (int i = 0; i < 8; ++i) x[i] = sigmoidf_(x[i]);
            }
            *(u32x4*)(ACT + tok * AST + c8) = (u32x4){pk2(x[0], x[1]), pk2(x[2], x[3]), pk2(x[4], x[5]), pk2(x[6], x[7])};
        }
        __syncthreads();
        const size_t hb = ((size_t)(b * 8 + wave) * SEQ + s0) * 64;
        const bf16* __restrict__ Rbr = A.Rb;
        unsigned char* stg = lds + 67584 + wave * 7344;
        u32x4 rowreg[7];
#define P3_ROWLOAD(TT, LN) do { _Pragma("unroll") for (int j = 0; j < 7; ++j) { const int task = (LN) + 64 * j; const int arr = task / 136, rem = task - arr * 136, row = rem >> 3, c16 = rem & 7; \
            const int tq = t0 + (TT) * 16 + row - 1; const bool ok = (task < 408) && !(row == 0 && ((t0 + (TT) * 16) % SEQ) == 0); \
            rowreg[j] = (u32x4){0u, 0u, 0u, 0u}; if (ok) rowreg[j] = *(const u32x4*)(Rbr + (size_t)tq * RW + arr * 512 + wave * 64 + c16 * 8); } } while (0)
        { int zo0; asm volatile("v_mov_b32 %0, 0" : "=v"(zo0)); P3_ROWLOAD(0, lane + zo0); }
#pragma unroll 1
        for (int tt = 0; tt < 8; ++tt) {
            int zo; asm volatile("v_mov_b32 %0, 0" : "=v"(zo));
            const int fr = fr0 + zo, fq = fq0 + zo, ln = lane + zo;
            const int tl = tt * 16 + fr, t = t0 + tl;
#pragma unroll
            for (int j = 0; j < 7; ++j) { const int task = ln + 64 * j; const int arr = task / 136, rem = task - arr * 136, row = rem >> 3, c16 = rem & 7;
                if (task < 408) *(u32x4*)(stg + (arr * 17 + row) * 144 + c16 * 16) = rowreg[j]; }
            LDS_WAIT();
            const bf16* actp = ACT + (tt * 16 + fr) * AST + fq * 8;
            f32x4 lwo[4]; u32x2 ro[4], ko[4], vo[4], aho[4], go[4];
            const f32x4 zz = (f32x4){0.f, 0.f, 0.f, 0.f};
            bf16x8 Wd[2], Wi[2], Wg[4];
#pragma unroll
            for (int ks = 0; ks < 2; ++ks) { Wd[ks] = *(const bf16x8*)(DUT + (((wave * 4 + 0) * 2 + ks) * 64 + ln) * 8); Wi[ks] = *(const bf16x8*)(IUT + (((wave * 4 + 0) * 2 + ks) * 64 + ln) * 8); }
#pragma unroll
            for (int ks = 0; ks < 4; ++ks) Wg[ks] = *(const bf16x8*)(GUT + (((wave * 4 + 0) * 4 + ks) * 64 + ln) * 8);
#pragma unroll
            for (int ct = 0; ct < 4; ++ct) {
                const int c4 = ct * 16 + fq * 4, ch = wave * 64 + c4;
                f32x4 ad = zz, ai = zz, ag = zz;
#pragma unroll
                for (int ks = 0; ks < 2; ++ks) {
                    ad = __builtin_amdgcn_mfma_f32_16x16x32_bf16(Wd[ks], *(const bf16x8*)(actp + ks * 32), ad, 0, 0, 0);
                    ai = __builtin_amdgcn_mfma_f32_16x16x32_bf16(Wi[ks], *(const bf16x8*)(actp + 64 + ks * 32), ai, 0, 0, 0);
                }
#pragma unroll
                for (int ks = 0; ks < 4; ++ks) ag = __builtin_amdgcn_mfma_f32_16x16x32_bf16(Wg[ks], *(const bf16x8*)(actp + 128 + ks * 32), ag, 0, 0, 0);
                if (ct < 3) {
#pragma unroll
                    for (int ks = 0; ks < 2; ++ks) { Wd[ks] = *(const bf16x8*)(DUT + (((wave * 4 + ct + 1) * 2 + ks) * 64 + ln) * 8); Wi[ks] = *(const bf16x8*)(IUT + (((wave * 4 + ct + 1) * 2 + ks) * 64 + ln) * 8); }
#pragma unroll
                    for (int ks = 0; ks < 4; ++ks) Wg[ks] = *(const bf16x8*)(GUT + (((wave * 4 + ct + 1) * 4 + ks) * 64 + ln) * 8);
                }
                const f32x4 w0 = *(const f32x4*)(A.w0 + ch), a0 = *(const f32x4*)(A.a0 + ch), ka = *(const f32x4*)(A.k_a + ch), rk = *(const f32x4*)(A.r_k + ch);
                const f32x4 mur = *(const f32x4*)(A.mu + ch), muk = *(const f32x4*)(A.mu + 512 + ch), muv = *(const f32x4*)(A.mu + 1024 + ch);
                const unsigned char* rs = stg + fr * 144 + c4 * 2;
                const f32x4 r0 = bf4(*(const u32x2*)(rs)), r1 = bf4(*(const u32x2*)(rs + 144));
                const f32x4 k0 = bf4(*(const u32x2*)(rs + 17 * 144)), k1 = bf4(*(const u32x2*)(rs + 18 * 144));
                const f32x4 v0 = bf4(*(const u32x2*)(rs + 34 * 144)), v1 = bf4(*(const u32x2*)(rs + 35 * 144));
                const f32x4 rm = r1 + (r0 - r1) * mur, km = k1 + (k0 - k1) * muk, vm = v1 + (v0 - v1) * muv;
                f32x4 lw, ah;
#pragma unroll
                for (int r = 0; r < 4; ++r) { lw[r] = -0.6065306597f * sigmoidf_(w0[r] + ad[r]); ah[r] = sigmoidf_(a0[r] + ai[r]); }
                const f32x4 kp = km * ((ah - 1.0f) * ka + 1.0f);
                const f32x4 pr3 = rm * kp * rk;
                float rks = (pr3[0] + pr3[1]) + (pr3[2] + pr3[3]);
                rks = rows4_sum(rks);
                if (fq == 0) RK[((size_t)t * 8 + wave) * 4 + ct] = rks;
                lwo[ct] = lw;
                ro[ct] = (u32x2){pk2(rm[0], rm[1]), pk2(rm[2], rm[3])}; ko[ct] = (u32x2){pk2(km[0], km[1]), pk2(km[2], km[3])};
                vo[ct] = (u32x2){pk2(vm[0], vm[1]), pk2(vm[2], vm[3])}; aho[ct] = (u32x2){pk2(ah[0], ah[1]), pk2(ah[2], ah[3])};
                go[ct] = (u32x2){pk2(ag[0], ag[1]), pk2(ag[2], ag[3])};
                asm volatile("" ::: "memory");
            }
            P3_ROWLOAD((tt < 7) ? tt + 1 : 7, ln);
            LDS_WAIT();
            const size_t ob = hb + (size_t)(tt * 16) * 64;
#define P3_STAGE_BF16(ARR, SRC) do { \
                _Pragma("unroll") for (int ct = 0; ct < 4; ++ct) *(u32x2*)(stg + fr * 144 + (ct * 16 + fq * 4) * 2) = SRC[ct]; \
                LDS_WAIT(); \
                _Pragma("unroll") for (int j = 0; j < 2; ++j) { const int tk = (ln >> 3) + 8 * j, c16 = ln & 7; \
                    const u32x4 v = *(const u32x4*)(stg + tk * 144 + c16 * 16); *(u32x4*)(ARR + ob + (size_t)tk * 64 + c16 * 8) = v; } \
                LDS_WAIT(); } while (0)
            P3_STAGE_BF16(Rr, ro); P3_STAGE_BF16(Kr, ko); P3_STAGE_BF16(Vr, vo); P3_STAGE_BF16(AH, aho); P3_STAGE_BF16(G, go);
#undef P3_STAGE_BF16
            {
#pragma unroll
                for (int ct = 0; ct < 4; ++ct) *(f32x4*)(stg + fr * 272 + (ct * 16 + fq * 4) * 4) = lwo[ct];
                LDS_WAIT();
#pragma unroll
                for (int j = 0; j < 4; ++j) { const int tk = (ln >> 4) + 4 * j, c4 = (ln & 15) * 4;
                    const f32x4 v = *(const f32x4*)(stg + tk * 272 + c4 * 4); *(f32x4*)(LW + ob + (size_t)tk * 64 + c4) = v; }
                LDS_WAIT();
            }
        }
#undef P3_ROWLOAD
    }
}

struct PAArgs { const float *k_k, *k_a; unsigned char* ws; unsigned char* dout; };
constexpr int MST = 72;
constexpr int MBYTES = 64 * MST * 2;

__device__ __forceinline__ void mm2(const bf16* A, const bf16* Bt, int ti, int tj0, int fr, int fq, f32x4& c0, f32x4& c1) {
#pragma unroll
    for (int ks = 0; ks < 2; ++ks) {
        const bf16x8 a = *(const bf16x8*)(A + (ti * 16 + fr) * MST + ks * 32 + fq * 8);
        const bf16x8 b0 = *(const bf16x8*)(Bt + (tj0 * 16 + fr) * MST + ks * 32 + fq * 8);
        const bf16x8 b1 = *(const bf16x8*)(Bt + (tj0 * 16 + 16 + fr) * MST + ks * 32 + fq * 8);
        c0 = __builtin_amdgcn_mfma_f32_16x16x32_bf16(a, b0, c0, 0, 0, 0);
        c1 = __builtin_amdgcn_mfma_f32_16x16x32_bf16(a, b1, c1, 0, 0, 0);
    }
}

struct ChunkRaw { float lwv[8]; bf16 rb[8], kb[8], vb[8], ab[8]; };
__device__ __forceinline__ void chunk_load(const PAArgs& A, int item, int wave, int lane, ChunkRaw& R) {
    const bf16* Rr = (const bf16*)(A.ws + WS_R); const bf16* Kr = (const bf16*)(A.ws + WS_K); const bf16* Vr = (const bf16*)(A.ws + WS_V);
    const bf16* AH = (const bf16*)(A.ws + WS_HBUF + 32 * MiB); const float* LW = (const float*)(A.ws + WS_LW);
    const int bh = item >> 6, ck = item & 63;
#pragma unroll
    for (int i = 0; i < 8; ++i) {
        const size_t o = ((size_t)bh * SEQ + ck * 64 + wave * 8 + i) * 64 + lane;
        R.lwv[i] = LW[o]; R.rb[i] = Rr[o]; R.kb[i] = Kr[o]; R.vb[i] = Vr[o]; R.ab[i] = AH[o];
    }
}
__device__ __forceinline__ void chunk_item(const PAArgs& A, unsigned char* lds, int item, int tid, int wave, int lane, const ChunkRaw& RAW) {
    bf16* AT = (bf16*)(lds + 0 * MBYTES); bf16* BT = (bf16*)(lds + 1 * MBYTES); bf16* KT = (bf16*)(lds + 2 * MBYTES); bf16* RT = (bf16*)(lds + 3 * MBYTES);
    bf16* BHT = (bf16*)(lds + 4 * MBYTES); bf16* KHT = (bf16*)(lds + 5 * MBYTES); bf16* VT = (bf16*)(lds + 6 * MBYTES);
    bf16* AAK = (bf16*)(lds + 7 * MBYTES); bf16* ARB = (bf16*)(lds + 8 * MBYTES); bf16* ARK = (bf16*)(lds + 9 * MBYTES);
    bf16* X1T = (bf16*)(lds + 10 * MBYTES); bf16* ZT = (bf16*)(lds + 11 * MBYTES);
    bf16* ATT = (bf16*)(lds + 12 * MBYTES); bf16* AVT = (bf16*)(lds + 13 * MBYTES); bf16* AABb = (bf16*)(lds + 14 * MBYTES);
    float* Dg = (float*)(lds + 15 * MBYTES);
    constexpr int TST = 20; bf16* Tinv = (bf16*)(lds + 15 * MBYTES + 4096);
    float* WCs = (float*)(lds + 15 * MBYTES + 4096 + 2560); float* CUMT = Dg;
    const bf16* Rr = (const bf16*)(A.ws + WS_R); const bf16* Kr = (const bf16*)(A.ws + WS_K); const bf16* Vr = (const bf16*)(A.ws + WS_V);
    const bf16* AH = (const bf16*)(A.ws + WS_HBUF + 32 * MiB); const float* LW = (const float*)(A.ws + WS_LW);
    float* Qg = (float*)(A.dout + DO_QG) + (size_t)item * 4096; bf16* Y0g = (bf16*)(A.dout + DO_Y0) + (size_t)item * 4096;
    bf16* RPg = (bf16*)(A.dout + DO_RP) + (size_t)item * 4096; bf16* Pg = (bf16*)(A.ws + WS_PG) + (size_t)item * 4096;
    const int bh = item >> 6, ck = item & 63, b = bh >> 3, h = bh & 7;
    const size_t tok0 = (size_t)b * SEQ + ck * 64;
    const int fr = lane & 15, fq = lane >> 4;
    LBAR();
    {
        const int ch = lane, tg = wave;
        float lwv[8], rv[8], kv[8], av[8], pl[8]; bf16 vb[8];
        float run = 0.f;
#pragma unroll
        for (int i = 0; i < 8; ++i) {
            lwv[i] = RAW.lwv[i]; rv[i] = bf2f(RAW.rb[i]); kv[i] = bf2f(RAW.kb[i]); vb[i] = RAW.vb[i]; av[i] = bf2f(RAW.ab[i]);
            run += lwv[i]; pl[i] = run;
        }
        CUMT[tg * 64 + ch] = run;
        LBAR();
        float off = 0.f, tot = 0.f;
#pragma unroll
        for (int g = 0; g < 8; ++g) { const float c = CUMT[g * 64 + ch]; tot += c; off += (g < tg) ? c : 0.f; }
        const float kkc = A.k_k[h * 64 + ch], kac = A.k_a[h * 64 + ch];
        const float etot = __expf(tot);
        unsigned bhp[4], khp[4], vp[4];
        float bhv[8], khv[8], atv[8];
#pragma unroll
        for (int i = 0; i < 8; ++i) {
            const float cl = off + pl[i], clp = cl - lwv[i];
            const float kq = kv[i] * kkc;
            const float kk = kq * __builtin_amdgcn_rsqf(fmaxf(wave_sum(kq * kq), 1e-24f));
            const float a_ = -kk, b_ = kk * av[i], kp = kv[i] * (1.0f + (av[i] - 1.0f) * kac);
            const float ecl = __expf(cl), encl = __builtin_amdgcn_rcpf(ecl), eclp = __expf(clp), eh = etot * encl;
            const int tok = tg * 8 + i;
            atv[i] = a_ * eclp; AT[tok * MST + ch] = (bf16)f2bf(a_ * eclp); BT[tok * MST + ch] = (bf16)f2bf(b_ * encl); KT[tok * MST + ch] = (bf16)f2bf(kp * encl); RT[tok * MST + ch] = (bf16)f2bf(rv[i] * ecl);
            bhv[i] = b_ * eh; khv[i] = kp * eh;
        }
#pragma unroll
        for (int i = 0; i < 4; ++i) { bhp[i] = pk2(bhv[2 * i], bhv[2 * i + 1]); khp[i] = pk2(khv[2 * i], khv[2 * i + 1]); vp[i] = (unsigned)vb[2 * i] | ((unsigned)vb[2 * i + 1] << 16); }
        *(u32x4*)(BHT + ch * MST + tg * 8) = (u32x4){bhp[0], bhp[1], bhp[2], bhp[3]};
        *(u32x4*)(KHT + ch * MST + tg * 8) = (u32x4){khp[0], khp[1], khp[2], khp[3]};
        *(u32x4*)(VT + ch * MST + tg * 8) = (u32x4){vp[0], vp[1], vp[2], vp[3]};
        *(u32x4*)(ATT + ch * MST + tg * 8) = (u32x4){pk2(atv[0], atv[1]), pk2(atv[2], atv[3]), pk2(atv[4], atv[5]), pk2(atv[6], atv[7])};
        if (tg == 0) WCs[ch] = etot;
    }
    LBAR();
    const int ti = wave >> 1, tj0 = (wave & 1) * 2;
    const f32x4 z4 = (f32x4){0.f, 0.f, 0.f, 0.f};
    {
        f32x4 c0 = z4, c1 = z4;
        const int jb = ti * 16 + fq * 4;
        const int ta = tj0 * 16 + fr, tb = ta + 16;
#define S3_MASK(c, t, INCL) (f32x4){ (jb + 0 < (t) + (INCL)) ? c[0] : 0.f, (jb + 1 < (t) + (INCL)) ? c[1] : 0.f, (jb + 2 < (t) + (INCL)) ? c[2] : 0.f, (jb + 3 < (t) + (INCL)) ? c[3] : 0.f }
        mm2(BT, AT, ti, tj0, fr, fq, c0, c1);
        { const f32x4 m0 = S3_MASK(c0, ta, 0), m1 = S3_MASK(c1, tb, 0);
          *(u32x2*)(AABb + ta * MST + jb) = (u32x2){pk2(m0[0], m0[1]), pk2(m0[2], m0[3])}; *(u32x2*)(AABb + tb * MST + jb) = (u32x2){pk2(m1[0], m1[1]), pk2(m1[2], m1[3])};
          if (tj0 == ti) *(f32x4*)(Dg + (ti * 16 + fr) * 16 + fq * 4) = m0;
          if (tj0 + 1 == ti) *(f32x4*)(Dg + (ti * 16 + fr) * 16 + fq * 4) = m1; }
        c0 = z4; c1 = z4; mm2(KT, AT, ti, tj0, fr, fq, c0, c1);
        { const f32x4 m0 = S3_MASK(c0, ta, 0), m1 = S3_MASK(c1, tb, 0);
          *(u32x2*)(AAK + ta * MST + jb) = (u32x2){pk2(m0[0], m0[1]), pk2(m0[2], m0[3])}; *(u32x2*)(AAK + tb * MST + jb) = (u32x2){pk2(m1[0], m1[1]), pk2(m1[2], m1[3])}; }
        c0 = z4; c1 = z4; mm2(BT, RT, ti, tj0, fr, fq, c0, c1);
        { const f32x4 m0 = S3_MASK(c0, ta, 1), m1 = S3_MASK(c1, tb, 1);
          *(u32x2*)(ARB + ta * MST + jb) = (u32x2){pk2(m0[0], m0[1]), pk2(m0[2], m0[3])}; *(u32x2*)(ARB + tb * MST + jb) = (u32x2){pk2(m1[0], m1[1]), pk2(m1[2], m1[3])}; }
        c0 = z4; c1 = z4; mm2(KT, RT, ti, tj0, fr, fq, c0, c1);
        { const f32x4 m0 = S3_MASK(c0, ta, 1), m1 = S3_MASK(c1, tb, 1);
          *(u32x2*)(ARK + ta * MST + jb) = (u32x2){pk2(m0[0], m0[1]), pk2(m0[2], m0[3])}; *(u32x2*)(ARK + tb * MST + jb) = (u32x2){pk2(m1[0], m1[1]), pk2(m1[2], m1[3])}; }
#undef S3_MASK
    }
    LBAR();
    {
        f32x4 c0 = z4, c1 = z4;
        mm2(AAK, VT, ti, tj0, fr, fq, c0, c1);
        *(u32x2*)(AVT + (tj0 * 16 + fr) * MST + ti * 16 + fq * 4) = (u32x2){pk2(c0[0], c0[1]), pk2(c0[2], c0[3])};
        *(u32x2*)(AVT + (tj0 * 16 + 16 + fr) * MST + ti * 16 + fq * 4) = (u32x2){pk2(c1[0], c1[1]), pk2(c1[2], c1[3])};
        if (wave == 0) {
            const int bi = lane >> 4, cc = lane & 15;
            float t[16];
#pragma unroll
            for (int r = 0; r < 16; ++r) {
                float acc = (r == cc) ? 1.f : 0.f;
#pragma unroll
                for (int k = 0; k < r; ++k) acc += Dg[(bi * 16 + r) * 16 + k] * t[k];
                t[r] = acc;
            }
#pragma unroll
            for (int r = 0; r < 16; ++r) Tinv[(bi * 16 + r) * TST + cc] = (bf16)f2bf(t[r]);
        }
    }
    LBAR();
    {
        typedef short s16x4 __attribute__((ext_vector_type(4)));
        const int cb = (wave & 3) * 16 + fr;
        const bf16* src = (wave < 4 ? ATT : AVT) + cb * MST;
        bf16* dst = (wave < 4 ? X1T : ZT) + cb * MST;
        s16x4 xb[4];
#pragma unroll
        for (int bi = 0; bi < 4; ++bi) {
            f32x4 acc = bf4(*(const u32x2*)(src + bi * 16 + fq * 4));
#pragma unroll
            for (int bj = 0; bj < bi; ++bj) acc = __builtin_amdgcn_mfma_f32_16x16x16bf16_1k(*(const s16x4*)(AABb + (bi * 16 + fr) * MST + bj * 16 + fq * 4), xb[bj], acc, 0, 0, 0);
            const u32x2 tb = (u32x2){pk2(acc[0], acc[1]), pk2(acc[2], acc[3])};
            const f32x4 xv = __builtin_amdgcn_mfma_f32_16x16x16bf16_1k(*(const s16x4*)(Tinv + (bi * 16 + fr) * TST + fq * 4), __builtin_bit_cast(s16x4, tb), z4, 0, 0, 0);
            const u32x2 xw = (u32x2){pk2(xv[0], xv[1]), pk2(xv[2], xv[3])};
            xb[bi] = __builtin_bit_cast(s16x4, xw);
            *(u32x2*)(dst + bi * 16 + fq * 4) = xw;
        }
    }
    LBAR();
    {
        f32x4 c0, c1;
        const int fl = lane * 4;
        { const u32x2 w0 = *(const u32x2*)(RT + (tj0 * 16 + fr) * MST + ti * 16 + fq * 4), w1 = *(const u32x2*)(RT + (tj0 * 16 + 16 + fr) * MST + ti * 16 + fq * 4);
          c0 = (f32x4){__uint_as_float(w0.x << 16), __uint_as_float(w0.x & 0xffff0000u), __uint_as_float(w0.y << 16), __uint_as_float(w0.y & 0xffff0000u)};
          c1 = (f32x4){__uint_as_float(w1.x << 16), __uint_as_float(w1.x & 0xffff0000u), __uint_as_float(w1.y << 16), __uint_as_float(w1.y & 0xffff0000u)}; }
        mm2(X1T, ARB, ti, tj0, fr, fq, c0, c1);
        const int fpos = (((ti >> 1) * 64) + ((ti & 1) * 2 + (fq >> 1)) * 16 + fr) * 8 + (fq & 1) * 4;
        *(u32x2*)(RPg + tj0 * 1024 + fpos) = (u32x2){pk2(c0[0], c0[1]), pk2(c0[2], c0[3])};
        *(u32x2*)(RPg + (tj0 + 1) * 1024 + fpos) = (u32x2){pk2(c1[0], c1[1]), pk2(c1[2], c1[3])};
        c0 = z4; c1 = z4; mm2(ZT, ARB, ti, tj0, fr, fq, c0, c1); mm2(VT, ARK, ti, tj0, fr, fq, c0, c1);
        *(u32x2*)(Y0g + (ti * 4 + tj0) * 256 + fl) = (u32x2){pk2(c0[0], c0[1]), pk2(c0[2], c0[3])};
        *(u32x2*)(Y0g + (ti * 4 + tj0 + 1) * 256 + fl) = (u32x2){pk2(c1[0], c1[1]), pk2(c1[2], c1[3])};
        c0 = z4; c1 = z4; mm2(X1T, BHT, ti, tj0, fr, fq, c0, c1);
        { const int chp = ti * 16 + fq * 4, cha = tj0 * 16 + fr, chb = cha + 16; const float wa = WCs[cha], wb = WCs[chb];
#pragma unroll
          for (int r = 0; r < 4; ++r) { c0[r] += (chp + r == cha) ? wa : 0.f; c1[r] += (chp + r == chb) ? wb : 0.f; }
          *(u32x2*)(Pg + tj0 * 1024 + fpos) = (u32x2){pk2(c0[0], c0[1]), pk2(c0[2], c0[3])};
          *(u32x2*)(Pg + (tj0 + 1) * 1024 + fpos) = (u32x2){pk2(c1[0], c1[1]), pk2(c1[2], c1[3])}; }
        c0 = z4; c1 = z4; mm2(BHT, ZT, ti, tj0, fr, fq, c0, c1); mm2(KHT, VT, ti, tj0, fr, fq, c0, c1);
        *(f32x4*)(Qg + (ti * 4 + tj0) * 256 + fl) = c0;
        *(f32x4*)(Qg + (ti * 4 + tj0 + 1) * 256 + fl) = c1;
    }
}

struct PBArgs { const float *lnx_g, *lnx_b; unsigned char* ws; unsigned char* dout; };

__device__ __forceinline__ void chunk_scan_m(const PBArgs& A, unsigned char* lds, int bh, int tid, int wave, int lane) {
    const float* Qg = (const float*)(A.dout + DO_QG); const bf16* Pg = (const bf16*)(A.ws + WS_PG);
    bf16* MC = (bf16*)(A.ws + WS_MC);
    const int fr = lane & 15, fq = lane >> 4, ti = wave >> 1, vj0 = (wave & 1) * 2;
    for (int i = tid; i < 64 * MST; i += 512) ((bf16*)lds)[i] = 0;
    const size_t item0 = (size_t)bh * 64;
    for (int i = tid; i < 512; i += 512) *(u32x4*)(MC + item0 * 4096 + (size_t)i * 8) = (u32x4){0u, 0u, 0u, 0u};
    LBAR();
    constexpr int PF = 4;
    bf16x8 aS[PF][2]; f32x4 cS[PF][2];
#pragma unroll
    for (int s = 0; s < PF; ++s) {
        const size_t it = (item0 + s) * 4096;
#pragma unroll
        for (int ks = 0; ks < 2; ++ks) aS[s][ks] = *(const bf16x8*)(Pg + it + ((ti * 2 + ks) * 64 + lane) * 8);
#pragma unroll
        for (int j = 0; j < 2; ++j) cS[s][j] = *(const f32x4*)(Qg + it + (ti * 4 + vj0 + j) * 256 + lane * 4);
    }
    const int fks = ti >> 1, ffq = (ti & 1) * 2 + (fq >> 1), fhalf = fq & 1;
    for (int ck0 = 0; ck0 < 64; ck0 += PF) {
#pragma unroll
        for (int s = 0; s < PF; ++s) {
            const int ck = ck0 + s;
            const bf16* cur = (const bf16*)(lds + (ck & 1) * MBYTES); bf16* nxt = (bf16*)(lds + ((ck + 1) & 1) * MBYTES);
            f32x4 c[2];
#pragma unroll
            for (int j = 0; j < 2; ++j) {
                c[j] = cS[s][j];
#pragma unroll
                for (int ks = 0; ks < 2; ++ks) c[j] = __builtin_amdgcn_mfma_f32_16x16x32_bf16(aS[s][ks], *(const bf16x8*)(cur + ((vj0 + j) * 16 + fr) * MST + ks * 32 + fq * 8), c[j], 0, 0, 0);
            }
            {
                const int ckn = (ck + PF < 64) ? ck + PF : 63;
                const size_t it = (item0 + ckn) * 4096;
#pragma unroll
                for (int ks = 0; ks < 2; ++ks) aS[s][ks] = *(const bf16x8*)(Pg + it + ((ti * 2 + ks) * 64 + lane) * 8);
#pragma unroll
                for (int j = 0; j < 2; ++j) cS[s][j] = *(const f32x4*)(Qg + it + (ti * 4 + vj0 + j) * 256 + lane * 4);
            }
#pragma unroll
            for (int j = 0; j < 2; ++j) {
                const u32x2 w = (u32x2){pk2(c[j][0], c[j][1]), pk2(c[j][2], c[j][3])};
                *(u32x2*)(nxt + ((vj0 + j) * 16 + fr) * MST + ti * 16 + fq * 4) = w;
                if (ck < 63) *(u32x2*)(MC + (item0 + ck + 1) * 4096 + ((((vj0 + j) * 2 + fks) * 64 + ffq * 16 + fr) * 8 + fhalf * 4)) = w;
            }
            LBAR();
        }
    }
}

__device__ __forceinline__ void chunk_out(const PBArgs& A, unsigned char* lds, int G_, int wave, int lane) {
    const bf16* Y0g = (const bf16*)(A.dout + DO_Y0); const bf16* RPg = (const bf16*)(A.dout + DO_RP); const bf16* MC = (const bf16*)(A.ws + WS_MC);
    const bf16* Vr = (const bf16*)(A.ws + WS_V); const bf16* Gt = (const bf16*)(A.ws + WS_HBUF); const float* RK = (const float*)(A.ws + WS_RK);
    bf16* YA = (bf16*)(A.ws + WS_YA);
    const int fr = lane & 15, fq = lane >> 4, tt = wave & 3, half = wave >> 2;
    unsigned char* ostg = lds + wave * 2304;
    bf16x8 nbR[2], naM[4][2]; u32x2 ny0[4]; u32x4 nrv[2], nrg[2]; f32x4 nr4;
#define CO_LOAD(IT) do { const int it_ = (IT); const int bh_ = it_ >> 6, ck_ = it_ & 63; const size_t ib_ = (size_t)it_ * 4096; \
        _Pragma("unroll") for (int ks = 0; ks < 2; ++ks) nbR[ks] = *(const bf16x8*)(RPg + ib_ + ((tt * 2 + ks) * 64 + lane) * 8); \
        _Pragma("unroll") for (int vi = 0; vi < 4; ++vi) { _Pragma("unroll") for (int ks = 0; ks < 2; ++ks) naM[vi][ks] = *(const bf16x8*)(MC + ib_ + ((vi * 2 + ks) * 64 + lane) * 8); \
            ny0[vi] = *(const u32x2*)(Y0g + ib_ + (vi * 4 + tt) * 256 + lane * 4); } \
        const size_t rbase_ = ((size_t)bh_ * SEQ + ck_ * 64 + tt * 16) * 64; \
        _Pragma("unroll") for (int j = 0; j < 2; ++j) { const int tk = (lane >> 3) + 8 * j, c16 = lane & 7; nrv[j] = *(const u32x4*)(Vr + rbase_ + (size_t)tk * 64 + c16 * 8); nrg[j] = *(const u32x4*)(Gt + rbase_ + (size_t)tk * 64 + c16 * 8); } \
        nr4 = *(const f32x4*)(RK + ((((size_t)(bh_ >> 3) * SEQ + ck_ * 64 + tt * 16 + fr) * 8 + (bh_ & 7)) * 4)); } while (0)
    const int it0 = blockIdx.x * 2 + half;
    if (it0 < 4096) CO_LOAD(it0);
    for (int it = it0; it < 4096; it += 2 * G_) {
        const int bh = it >> 6, ck = it & 63, b = bh >> 3, h = bh & 7;
        bf16x8 bR[2], aM[4][2]; u32x2 y0[4], vv[4], gg[4]; u32x4 rv[2], rg[2];
#pragma unroll
        for (int ks = 0; ks < 2; ++ks) bR[ks] = nbR[ks];
#pragma unroll
        for (int vi = 0; vi < 4; ++vi) { aM[vi][0] = naM[vi][0]; aM[vi][1] = naM[vi][1]; y0[vi] = ny0[vi]; }
#pragma unroll
        for (int j = 0; j < 2; ++j) { rv[j] = nrv[j]; rg[j] = nrg[j]; }
        const float rk = (nr4[0] + nr4[1]) + (nr4[2] + nr4[3]);
        {
#pragma unroll
            for (int j = 0; j < 2; ++j) { const int tk = (lane >> 3) + 8 * j, c16 = lane & 7; *(u32x4*)(ostg + tk * 144 + c16 * 16) = rv[j]; }
            LDS_WAIT();
#pragma unroll
            for (int vi = 0; vi < 4; ++vi) vv[vi] = *(const u32x2*)(ostg + fr * 144 + (vi * 16 + fq * 4) * 2);
            LDS_WAIT();
#pragma unroll
            for (int j = 0; j < 2; ++j) { const int tk = (lane >> 3) + 8 * j, c16 = lane & 7; *(u32x4*)(ostg + tk * 144 + c16 * 16) = rg[j]; }
            LDS_WAIT();
#pragma unroll
            for (int vi = 0; vi < 4; ++vi) gg[vi] = *(const u32x2*)(ostg + fr * 144 + (vi * 16 + fq * 4) * 2);
            LDS_WAIT();
        }
        f32x4 c[4];
#pragma unroll
        for (int vi = 0; vi < 4; ++vi) {
            c[vi] = bf4(y0[vi]);
#pragma unroll
            for (int ks = 0; ks < 2; ++ks) c[vi] = __builtin_amdgcn_mfma_f32_16x16x32_bf16(aM[vi][ks], bR[ks], c[vi], 0, 0, 0);
        }
        { const int itn = (it + 2 * G_ < 4096) ? it + 2 * G_ : it; CO_LOAD(itn); }
        float sm = 0.f;
#pragma unroll
        for (int vi = 0; vi < 4; ++vi) sm += (c[vi][0] + c[vi][1]) + (c[vi][2] + c[vi][3]);
        sm = rows4_sum(sm);
        const float mu = sm * (1.0f / 64.0f);
        float q = 0.f;
#pragma unroll
        for (int vi = 0; vi < 4; ++vi) { c[vi] = c[vi] - mu; q += (c[vi][0] * c[vi][0] + c[vi][1] * c[vi][1]) + (c[vi][2] * c[vi][2] + c[vi][3] * c[vi][3]); }
        q = rows4_sum(q);
        const float rs = rsqrtf(q * (1.0f / 64.0f) + 64e-5f);
#pragma unroll
        for (int vi = 0; vi < 4; ++vi) {
            const f32x4 lg = *(const f32x4*)(A.lnx_g + h * 64 + vi * 16 + fq * 4), lb = *(const f32x4*)(A.lnx_b + h * 64 + vi * 16 + fq * 4);
            const f32x4 o = (c[vi] * rs * lg + lb + bf4(vv[vi]) * rk) * bf4(gg[vi]);
            *(u32x2*)(ostg + fr * 144 + (vi * 16 + fq * 4) * 2) = (u32x2){pk2(o[0], o[1]), pk2(o[2], o[3])};
        }
        LDS_WAIT();
#pragma unroll
        for (int j = 0; j < 2; ++j) {
            const int tk = (lane >> 3) + 8 * j, c16 = lane & 7;
            const size_t tg = (size_t)b * SEQ + ck * 64 + tt * 16 + tk;
            *(u32x4*)(YA + tg * 512 + h * 64 + c16 * 8) = *(const u32x4*)(ostg + tk * 144 + c16 * 16);
        }
        LDS_WAIT();
    }
#undef CO_LOAD
}

struct AtArgs { const float *qg, *kg, *sinks; const int* pos; unsigned char* ws; };

__device__ __forceinline__ void rope_entry(int pos, int j, float& cs, float& sn) {
    const double fr[8] = {0.15915494309189535, 0.03086376340470123, 0.005985185712713705, 0.001160663641240061, 0.00022507907903927653, 4.364795279280289e-05, 8.464330808241401e-06, 1.6414262627950345e-06};
    double f0 = fr[0];
#pragma unroll
    for (int i = 1; i < 8; ++i) f0 = (j == i) ? fr[i] : f0;
    const double tt = (double)pos * f0;
    const float f = (float)(tt - __builtin_floor(tt));
    sn = __builtin_amdgcn_sinf(f); cs = __builtin_amdgcn_cosf(f);
}
__device__ __forceinline__ void rope16(float* x, const float* rp) {
    const f32x4 c0 = *(const f32x4*)rp, c1 = *(const f32x4*)(rp + 4), s0 = *(const f32x4*)(rp + 8), s1 = *(const f32x4*)(rp + 12);
#pragma unroll
    for (int i = 0; i < 8; ++i) {
        const float cs = (i < 4) ? c0[i & 3] : c1[i & 3], sn = (i < 4) ? s0[i & 3] : s1[i & 3];
        const float x1 = x[i], x2 = x[8 + i];
        x[i] = x1 * cs - x2 * sn; x[8 + i] = x2 * cs + x1 * sn;
    }
}
__device__ __forceinline__ void norm_rope(u32x4 w0, u32x4 w1, const float* __restrict__ gain, int chunk, const float* rp, float scale, float* x) {
    const unsigned ww[8] = {w0.x, w0.y, w0.z, w0.w, w1.x, w1.y, w1.z, w1.w};
    float ss = 0.f;
#pragma unroll
    for (int i = 0; i < 8; ++i) { x[2 * i] = __uint_as_float(ww[i] << 16); x[2 * i + 1] = __uint_as_float(ww[i] & 0xffff0000u); ss += x[2 * i] * x[2 * i] + x[2 * i + 1] * x[2 * i + 1]; }
    ss += dpp_perm<0xB1, 0xF>(ss); ss += dpp_perm<0x4E, 0xF>(ss);
    const float inv = rsqrtf(ss * (1.0f / 64.0f) + 1e-6f);
#pragma unroll
    for (int i = 0; i < 16; ++i) x[i] = x[i] * inv * gain[chunk * 16 + i];
    if (chunk == 0) rope16(x, rp);
#pragma unroll
    for (int i = 0; i < 16; ++i) x[i] *= scale;
}
__device__ __forceinline__ void load_norm_rope(const bf16* p, bool valid, const float* __restrict__ gain, int chunk, const float* rp, float scale, float* x) {
    u32x4 w0 = (u32x4){0, 0, 0, 0}, w1 = w0;
    if (valid) { w0 = *(const u32x4*)p; w1 = *(const u32x4*)(p + 8); }
    norm_rope(w0, w1, gain, chunk, rp, scale, x);
}

__device__ __forceinline__ void attn_unit(const AtArgs& A, unsigned char* lds, int unit, int tid, int wave, int lane) {
    constexpr int KST = 72, VST = 280, PST = 168, QST = 72;
    bf16* KS = (bf16*)lds;
    bf16* VT = (bf16*)(lds + 36864);
    bf16* PS = (bf16*)(lds + 36864 + 35840) + wave * 16 * PST;
    bf16* QS = (bf16*)(lds + 36864 + 35840 + 8 * 16 * PST * 2) + wave * 16 * QST;
    const bf16* Q = (const bf16*)(A.ws + WS_QKVG); bf16* YB = (bf16*)(A.ws + WS_YB);
    const int b = unit >> 6, kvh = (unit >> 5) & 1, nb = unit & 31;
    const int fr = lane & 15, fq = lane >> 4;
    const float* ROPE = (const float*)(A.ws + WS_ROPE);
    u32x4 qn0, qn1;
    const bf16* pq0;
    {
        const int g_ = wave >> 1, qh_ = wave & 1, hq_ = kvh * 4 + g_, row = lane >> 2, chunk = lane & 3;
        const size_t t = (size_t)b * SEQ + nb * 128 + qh_ * 64 + row;
        pq0 = Q + t * QW + QC_Q + hq_ * 64 + chunk * 16;
        qn0 = *(const u32x4*)pq0; qn1 = *(const u32x4*)(pq0 + 8);
    }
    LBAR();
#pragma unroll
    for (int rep = 0; rep < 2; ++rep) {
        const int task = tid + rep * 512, key = task >> 2, chunk = task & 3;
        const int s = (nb - 1) * 128 + key; const bool valid = s >= 0;
        const size_t t = (size_t)b * SEQ + (valid ? s : 0);
        float x[16];
        load_norm_rope(Q + t * QW + QC_K + kvh * 64 + chunk * 16, valid, A.kg, chunk, ROPE + t * 16, 1.0f, x);
        u32x4 o0, o1; o0.x = pk2(x[0], x[1]); o0.y = pk2(x[2], x[3]); o0.z = pk2(x[4], x[5]); o0.w = pk2(x[6], x[7]); o1.x = pk2(x[8], x[9]); o1.y = pk2(x[10], x[11]); o1.z = pk2(x[12], x[13]); o1.w = pk2(x[14], x[15]);
        *(u32x4*)(KS + key * KST + chunk * 16) = o0; *(u32x4*)(KS + key * KST + chunk * 16 + 8) = o1;
    }
#pragma unroll
    for (int rep = 0; rep < 4; ++rep) {
        const int task = tid + rep * 512, key = task >> 3, c8 = task & 7;
        const int s = (nb - 1) * 128 + key; const bool valid = s >= 0;
        const size_t t = (size_t)b * SEQ + (valid ? s : 0);
        u32x4 w = (u32x4){0, 0, 0, 0};
        if (valid) w = *(const u32x4*)(Q + t * QW + QC_V + kvh * 64 + c8 * 8);
        const unsigned ww[4] = {w.x, w.y, w.z, w.w};
#pragma unroll
        for (int i = 0; i < 4; ++i) { VT[(c8 * 8 + 2 * i) * VST + key] = (bf16)(ww[i] & 0xffffu); VT[(c8 * 8 + 2 * i + 1) * VST + key] = (bf16)(ww[i] >> 16); }
    }
    for (int i = tid; i < 64 * 24; i += 512) VT[(i / 24) * VST + 256 + (i % 24)] = 0;
    LBAR();
    const int g = wave >> 1, qh = wave & 1, hq = kvh * 4 + g;
    const float sink = A.sinks[hq];
#pragma unroll 1
    for (int st = 0; st < 4; ++st) {
        const int q0 = qh * 64 + st * 16;
        {
            const int row = lane >> 2, chunk = lane & 3;
            const size_t t = (size_t)b * SEQ + nb * 128 + q0 + row;
            float x[16];
            const u32x4 qc0 = qn0, qc1 = qn1;
            { const bf16* pn = pq0 + (size_t)((st < 3) ? st + 1 : 3) * 16 * QW; qn0 = *(const u32x4*)pn; qn1 = *(const u32x4*)(pn + 8); }
            norm_rope(qc0, qc1, A.qg, chunk, ROPE + t * 16, 0.125f, x);
            u32x4 o0, o1; o0.x = pk2(x[0], x[1]); o0.y = pk2(x[2], x[3]); o0.z = pk2(x[4], x[5]); o0.w = pk2(x[6], x[7]); o1.x = pk2(x[8], x[9]); o1.y = pk2(x[10], x[11]); o1.z = pk2(x[12], x[13]); o1.w = pk2(x[14], x[15]);
            *(u32x4*)(QS + row * QST + chunk * 16) = o0; *(u32x4*)(QS + row * QST + chunk * 16 + 8) = o1;
        }
        LBAR();
        const bf16x8 qa0 = *(const bf16x8*)(QS + fr * QST + fq * 8), qa1 = *(const bf16x8*)(QS + fr * QST + 32 + fq * 8);
        f32x4 sc[9];
#pragma unroll
        for (int kt = 0; kt < 9; ++kt) {
            const int key = (q0 / 16 + kt) * 16 + fr;
            const bf16x8 kb0 = *(const bf16x8*)(KS + key * KST + fq * 8), kb1 = *(const bf16x8*)(KS + key * KST + 32 + fq * 8);
            f32x4 a = (f32x4){0.f, 0.f, 0.f, 0.f};
            a = __builtin_amdgcn_mfma_f32_16x16x32_bf16(qa0, kb0, a, 0, 0, 0); a = __builtin_amdgcn_mfma_f32_16x16x32_bf16(qa1, kb1, a, 0, 0, 0);
#pragma unroll
            for (int r = 0; r < 4; ++r) {
                const int qi = q0 + fq * 4 + r;
                const bool ok = (key > qi) && (key <= qi + 128) && (nb > 0 || key >= 128);
                a[r] = ok ? a[r] : -1e30f;
            }
            sc[kt] = a;
        }
        float m4[4], s4[4];
#pragma unroll
        for (int r = 0; r < 4; ++r) {
            float m = sc[0][r];
#pragma unroll
            for (int kt = 1; kt < 9; ++kt) m = fmaxf(m, sc[kt][r]);
            m = row16_max(m);
            m4[r] = fmaxf(m, sink);
            float s = 0.f;
#pragma unroll
            for (int kt = 0; kt < 9; ++kt) { const float e = __expf(sc[kt][r] - m4[r]); sc[kt][r] = e; s += e; }
            s = row16_sum(s);
            s4[r] = __builtin_amdgcn_rcpf(s + __expf(sink - m4[r]));
        }
#pragma unroll
        for (int kt = 0; kt < 9; ++kt)
#pragma unroll
            for (int r = 0; r < 4; ++r) PS[(fq * 4 + r) * PST + kt * 16 + fr] = (bf16)f2bf(sc[kt][r] * s4[r]);
#pragma unroll
        for (int r = 0; r < 4; ++r) PS[(fq * 4 + r) * PST + 144 + fr] = 0;
        LBAR();
        f32x4 o[4];
#pragma unroll
        for (int dt = 0; dt < 4; ++dt) o[dt] = (f32x4){0.f, 0.f, 0.f, 0.f};
#pragma unroll
        for (int ks = 0; ks < 5; ++ks) {
            const bf16x8 pa = *(const bf16x8*)(PS + fr * PST + ks * 32 + fq * 8);
#pragma unroll
            for (int dt = 0; dt < 4; ++dt) {
                const bf16x8 vb = *(const bf16x8*)(VT + (dt * 16 + fr) * VST + q0 + ks * 32 + fq * 8);
                o[dt] = __builtin_amdgcn_mfma_f32_16x16x32_bf16(pa, vb, o[dt], 0, 0, 0);
            }
        }
        LDS_WAIT();
#pragma unroll
        for (int r = 0; r < 4; ++r)
#pragma unroll
            for (int dt = 0; dt < 4; ++dt) PS[(fq * 4 + r) * PST + dt * 16 + fr] = (bf16)f2bf(o[dt][r]);
        LDS_WAIT();
#pragma unroll
        for (int j = 0; j < 2; ++j) {
            const int tk = (lane >> 3) + 8 * j, c16 = lane & 7;
            const size_t t = (size_t)b * SEQ + nb * 128 + q0 + tk;
            *(u32x4*)(YB + t * 512 + hq * 64 + c16 * 8) = *(const u32x4*)(PS + tk * PST + c16 * 8);
        }
        LBAR();
    }
}

#define XB_TMO      128
#define XB_XCNT(j)  (256  + 64 * (j))
#define XB_XSUB(j)  (1280 + 64 * (j))
#define XB_XGEN(j)  (2304 + 64 * (j))
#define XB_TOP      3328
#define XB_TOPGEN   3392
#define XCD_BAR_WORDS 3456
#define XB_SPIN_CAP (1u << 18)

__device__ __forceinline__ unsigned xb_ld(unsigned* p)              { return __hip_atomic_load(p, __ATOMIC_RELAXED, __HIP_MEMORY_SCOPE_AGENT); }
__device__ __forceinline__ unsigned xb_add(unsigned* p, unsigned v) { return __hip_atomic_fetch_add(p, v, __ATOMIC_RELAXED, __HIP_MEMORY_SCOPE_AGENT); }
__device__ __forceinline__ unsigned xb_xcc_id() { return (unsigned)__builtin_amdgcn_s_getreg((3 << 11) | 20) & 0xFu; }
#define XB_SPIN(cond, bar) do { unsigned _sp = 0; while (cond) { __builtin_amdgcn_s_sleep(1); \
    if ((++_sp & 255u) == 0u) { if (xb_ld(&(bar)[XB_TMO])) break; if (_sp > XB_SPIN_CAP) { atomicAdd(&(bar)[XB_TMO], 1u); break; } } } } while (0)

struct XcdBarrier {
    unsigned* bar; unsigned x;
    volatile LAS unsigned* st;
};

__device__ __forceinline__ XcdBarrier xcd_barrier_post(unsigned* bar, volatile LAS unsigned* st) {
    XcdBarrier b; b.bar = bar; b.x = xb_xcc_id(); b.st = st;
    if (threadIdx.x == 0) (void)xb_add(&bar[XB_XCNT(b.x)], 1u);
    return b;
}
__device__ __forceinline__ void xcd_barrier_complete(unsigned* bar, unsigned x, unsigned& nloc, unsigned& nx) {
    const unsigned G = gridDim.x * gridDim.y * gridDim.z;
    unsigned sum, cnt, mine, sp = 0u;
    for (;;) {
        sum = 0u; cnt = 0u; mine = 0u;
#pragma unroll
        for (unsigned j = 0; j < 16; ++j) { const unsigned c = xb_ld(&bar[XB_XCNT(j)]); sum += c; cnt += (c > 0u) ? 1u : 0u; mine = (j == x) ? c : mine; }
        if (sum == G) break;
        __builtin_amdgcn_s_sleep(1);
        if ((++sp & 255u) == 0u) { if (xb_ld(&bar[XB_TMO])) break; if (sp > XB_SPIN_CAP) { atomicAdd(&bar[XB_TMO], 1u); break; } }
    }
    nloc = mine > 0u ? mine : 1u; nx = cnt > 0u ? cnt : 1u;
}

__device__ __forceinline__ void xcd_barrier(const XcdBarrier& b) {
    asm volatile("s_waitcnt vmcnt(0)" ::: "memory");
    __syncthreads();
    if (threadIdx.x == 0) {
        unsigned* bar = b.bar;
        __builtin_amdgcn_s_waitcnt(0);
        unsigned nloc = b.st[0], nx = b.st[1];
        if (nloc == 0u) { xcd_barrier_complete(bar, b.x, nloc, nx); b.st[0] = nloc; b.st[1] = nx; }
        const unsigned old = xb_add(&bar[XB_XSUB(b.x)], 1u);
        const unsigned gen = old / nloc;
        if (old + 1u == (gen + 1u) * nloc) {
            __builtin_amdgcn_fence(__ATOMIC_RELEASE, "agent");
            asm volatile("s_waitcnt vmcnt(0)" ::: "memory");
            const unsigned og = xb_add(&bar[XB_TOP], 1u);
            const unsigned tg = og / nx;
            if (og + 1u == (tg + 1u) * nx) xb_add(&bar[XB_TOPGEN], 1u);
            else XB_SPIN(xb_ld(&bar[XB_TOPGEN]) == tg, bar);
            __builtin_amdgcn_fence(__ATOMIC_ACQUIRE, "agent");
            xb_add(&bar[XB_XGEN(b.x)], 1u);
            asm volatile("s_waitcnt vmcnt(0)" ::: "memory");
        } else {
            XB_SPIN(xb_ld(&bar[XB_XGEN(b.x)]) == gen, bar);
            __builtin_amdgcn_fence(__ATOMIC_ACQUIRE, "agent");
            asm volatile("s_waitcnt vmcnt(0)" ::: "memory");
        }
    }
    __syncthreads();
}

struct Args { const void* in[29]; float* out; unsigned char* ws; };

__global__ void __launch_bounds__(512, 2) mega_fwd(Args a) {
    extern __shared__ __attribute__((aligned(16))) unsigned char lds[];
    cg::grid_group grid = cg::this_grid();
    const int wave = __builtin_amdgcn_readfirstlane(threadIdx.x >> 6);
    const int G = gridDim.x, NGW = G * 8, NGT = G * 512;
#define THREAD_IDS() const int lane = pg8::lane_id_fresh(); const int tid = wave * 64 + lane; const int gw = blockIdx.x * 8 + wave; const int gt = blockIdx.x * 512 + tid; (void)gw; (void)gt; (void)tid; (void)lane
    unsigned char* ws = a.ws;
    const float* x = (const float*)a.in[0];
    LAS unsigned char* ldsl = (LAS unsigned char*)lds;
    volatile LAS unsigned* bst = (volatile LAS unsigned*)(ldsl + LDS_BYTES - 16);
    unsigned* barw = (unsigned*)(ws + 0);
    if (threadIdx.x < 2) bst[threadIdx.x] = 0u;
    __syncthreads();
    if (a.ws == nullptr) grid.sync();
    XcdBarrier xbar = xcd_barrier_post(barw, bst);
#define GSYNC() xcd_barrier(xbar)

#ifndef REP_P0
#define REP_P0 1
#endif
#ifndef REP_P1
#define REP_P1 1
#endif
#ifndef REP_P2
#define REP_P2 1
#endif
#ifndef REP_P3
#define REP_P3 1
#endif
#ifndef REP_P4A
#define REP_P4A 1
#endif
#ifndef REP_P4B
#define REP_P4B 1
#endif
#ifndef REP_SCAN
#define REP_SCAN 1
#endif
#ifndef REP_ATT
#define REP_ATT 1
#endif
#ifndef REP_P6
#define REP_P6 1
#endif
#ifndef REP_P7
#define REP_P7 1
#endif
#ifndef REP_P8
#define REP_P8 1
#endif
#ifndef REP_P9
#define REP_P9 1
#endif
    for (int rep = 0; rep < REP_P0; ++rep) {
        THREAD_IDS();
        P0Args p{(const float*)a.in[7], (const float*)a.in[23], (const float*)a.in[24], (const float*)a.in[25], (const float*)a.in[26], (const float*)a.in[27], (const float*)a.in[28],
                 (const float*)a.in[3], (const float*)a.in[1], (const float*)a.in[10], (const float*)a.in[12], (const float*)a.in[13], ws};
        phase0(p, ldsl, gw, NGW, wave, lane, gt, NGT);
        GSYNC();
    }
#ifndef REP_SYNC
#define REP_SYNC 0
#endif
    for (int rs = 0; rs < REP_SYNC; ++rs) GSYNC();
    for (int rep = 0; rep < REP_P1; ++rep) {
        THREAD_IDS();
        const float* ada_b = (const float*)a.in[4];
        norm_mod_phase<true>(x, (const float*)a.in[5], ada_b, ws, 0, 1024, (bf16*)(ws + WS_HBUF), gw, NGW, lane);
        { const int* pos = (const int*)a.in[2]; float* rope = (float*)(ws + WS_ROPE);
          for (int i = gt; i < T * 8; i += NGT) { float cs, sn; rope_entry(pos[i >> 3], i & 7, cs, sn); rope[(size_t)(i >> 3) * 16 + (i & 7)] = cs; rope[(size_t)(i >> 3) * 16 + 8 + (i & 7)] = sn; } }
        const float* adap = (const float*)(ws + WS_ADAP); float* ada = (float*)(ws + WS_ADA);
        for (int i = gt; i < 8 * ADAW; i += NGT) { const int b = i / ADAW, j = i % ADAW; float s = ada_b[j]; for (int ks = 0; ks < KSPLIT; ++ks) s += adap[(size_t)(ks * 8 + b) * ADAW + j]; ada[i] = s; }
        GSYNC();
    }
    for (int rep = 0; rep < REP_P2; ++rep) {
        pg8::Gemm g{(const bf16*)(ws + WS_HBUF), (const bf16*)(ws + WS_WIN), T, INW, D, D}; pg8::StaticOrder S; S.init(T, INW, G, (int)blockIdx.x);
        EpiProj E{(bf16*)a.out, (bf16*)(ws + WS_QKVG), (const float*)a.in[22]};
        pg8::gemm_phase<EpiProj, pg8::StaticOrder, true, true>(ldsl, g, S, E, wave);
        GSYNC();
    }
    for (int rep = 0; rep < REP_P3; ++rep) {
        THREAD_IDS();
        P3Args p{(const bf16*)a.out, (const float*)a.in[8], (const float*)a.in[9], (const float*)a.in[11], (const float*)a.in[15], (const float*)a.in[16], ws};
        phase3(p, lds, tid, wave, lane);
        GSYNC();
    }
    for (int rep = 0; rep < REP_P4A; ++rep) {
        THREAD_IDS();
        PAArgs p{(const float*)a.in[14], (const float*)a.in[15], ws, (unsigned char*)a.out};
        ChunkRaw raw; chunk_load(p, blockIdx.x, wave, lane, raw);
        for (int it = blockIdx.x; it < 4096; it += G) {
            const ChunkRaw cur = raw;
            { const int nx = (it + G < 4096) ? it + G : it; chunk_load(p, nx, wave, lane, raw); }
            chunk_item(p, lds, it, tid, wave, lane, cur);
        }
        GSYNC();
    }
    for (int rep = 0; rep < REP_P4B; ++rep) {
        THREAD_IDS();
        if (blockIdx.x < 64) {
            PBArgs p{(const float*)a.in[17], (const float*)a.in[18], ws, (unsigned char*)a.out};
            for (int r2 = 0; r2 < REP_SCAN; ++r2) chunk_scan_m(p, lds, blockIdx.x, tid, wave, lane);
        } else {
            AtArgs p{(const float*)a.in[19], (const float*)a.in[20], (const float*)a.in[21], (const int*)a.in[2], ws};
            for (int r2 = 0; r2 < REP_ATT; ++r2) for (int u = blockIdx.x - 64; u < 512; u += G - 64) attn_unit(p, lds, u, tid, wave, lane);
        }
        GSYNC();
    }
    {
        THREAD_IDS();
        PBArgs p{(const float*)a.in[17], (const float*)a.in[18], ws, (unsigned char*)a.out};
        chunk_out(p, lds, G, wave, lane);
        GSYNC();
    }
    for (int rep = 0; rep < REP_P6; ++rep) {
        pg8::StaticOrder S; S.init(T, D, G, (int)blockIdx.x);
        { pg8::Gemm g{(const bf16*)(ws + WS_YA), (const bf16*)(ws + WS_WA), T, D, 512, 512}; EpiBranch<0> E{(const bf16*)(ws + WS_QKVG), a.out, (bf16*)(ws + WS_HBUF)};
          pg8::gemm_phase<EpiBranch<0>, pg8::StaticOrder, true, true>(ldsl, g, S, E, wave); }
        { pg8::Gemm g{(const bf16*)(ws + WS_YB), (const bf16*)(ws + WS_WB), T, D, 512, 512}; EpiBranch<1> E{(const bf16*)(ws + WS_QKVG), a.out, (bf16*)(ws + WS_HBUF)};
          pg8::gemm_phase<EpiBranch<1>, pg8::StaticOrder, true, true>(ldsl, g, S, E, wave); }
        GSYNC();
    }
    for (int rep = 0; rep < REP_P7; ++rep) {
        pg8::Gemm g{(const bf16*)(ws + WS_HBUF), (const bf16*)(ws + WS_WOUT), T, D, D, D}; pg8::StaticOrder S; S.init(T, D, G, (int)blockIdx.x);
        EpiResNorm E{x, a.out, (const float*)(ws + WS_ADA) + 2048, (const float*)(ws + WS_ADA), (const float*)a.in[6], (float*)(ws + WS_SLOT), (unsigned*)(ws + 16384), (bf16*)(ws + WS_HBUF)};
        pg8::gemm_phase<EpiResNorm, pg8::StaticOrder, true, true>(ldsl, g, S, E, wave);
        GSYNC();
    }
    for (int rep = 0; rep < REP_P8 - 1; ++rep) {
        THREAD_IDS();
        norm_mod_phase<false>(a.out, (const float*)a.in[6], (const float*)a.in[4], ws, 3072, 4096, (bf16*)(ws + WS_HBUF), gw, NGW, lane);
        GSYNC();
    }
    for (int rep = 0; rep < REP_P9; ++rep) {
        pg8::Gemm g{(const bf16*)(ws + WS_HBUF), (const bf16*)(ws + WS_W13), T, 2 * FF, D, D}; pg8::StaticOrder S; S.init(T, 2 * FF, G, (int)blockIdx.x);
        EpiSwiglu E{(bf16*)(ws + WS_QKVG)};
        pg8::gemm_phase<EpiSwiglu, pg8::StaticOrder, true, true>(ldsl, g, S, E, wave);
        GSYNC();
    }
    {
        pg8::Gemm g{(const bf16*)(ws + WS_QKVG), (const bf16*)(ws + WS_W2), T, D, FF, FF}; pg8::StaticOrder S; S.init(T, D, G, (int)blockIdx.x);
        EpiRes E{a.out, a.out, (const float*)(ws + WS_ADA) + 5120};
        pg8::gemm_phase<EpiRes, pg8::StaticOrder, true, true>(ldsl, g, S, E, wave);
    }
}

extern "C" void kernel_launch(void* const* d_in, const int* in_sizes, int n_in, void* d_out, int out_size, void* d_ws, size_t ws_size, hipStream_t stream) {
    static int grid_blocks = 0;
    if (grid_blocks == 0) {
        if (n_in != 29 || out_size != T * D || ws_size < WS_END) { fprintf(stderr, "kernel_launch: unexpected shapes (n_in %d out %d ws %zu)\n", n_in, out_size, ws_size); grid_blocks = -1; return; }
        int dev = 0, cus = 0, per_cu = 0;
        hipGetDevice(&dev);
        hipDeviceGetAttribute(&cus, hipDeviceAttributeMultiprocessorCount, dev);
        hipFuncSetAttribute((const void*)mega_fwd, hipFuncAttributeMaxDynamicSharedMemorySize, LDS_BYTES);
        hipOccupancyMaxActiveBlocksPerMultiprocessor(&per_cu, (const void*)mega_fwd, 512, LDS_BYTES);
        if (per_cu < 1) { fprintf(stderr, "kernel_launch: occupancy query gives %d\n", per_cu); per_cu = 1; }
        (void)hipGetLastError();
        grid_blocks = cus * per_cu;
    }
    if (grid_blocks < 0) return;
    if (hipMemsetAsync(d_ws, 0, 32768, stream) != hipSuccess) { fprintf(stderr, "kernel_launch: memset of the barrier words failed\n"); return; }
    Args a{};
    for (int i = 0; i < 29; ++i) a.in[i] = d_in[i];
    a.out = (float*)d_out; a.ws = (unsigned char*)d_ws;
    void* args[] = {&a};
    hipError_t e = hipLaunchCooperativeKernel((const void*)mega_fwd, dim3(grid_blocks), dim3(512), args, LDS_BYTES, stream);
    if (e != hipSuccess) fprintf(stderr, "cooperative launch failed: %s (grid %d)\n", hipGetErrorString(e), grid_blocks);
}
```

```cpp
#include <hip/hip_runtime.h>
#include <hip/hip_cooperative_groups.h>
#include <cstdio>
#include <cstdint>
namespace cg = cooperative_groups;

namespace pg8 {
#define PG8_LAS __attribute__((address_space(3)))
typedef unsigned short bf16_t;
typedef short bf16x8 __attribute__((ext_vector_type(8)));
typedef float f32x4 __attribute__((ext_vector_type(4)));
typedef unsigned u32x4 __attribute__((ext_vector_type(4)));
constexpr int BM = 256, BK = 64, HALF = 128, HTB = HALF * BK * 2  , STAGE_BYTES = 8 * HTB, NXCD = 8, WGM = 8;

__host__ __device__ __forceinline__ int lds_byte(int r, int c) { const int st = (r >> 4) * 2 + (c >> 5), rr = r & 15, cc = c & 31, ob = rr * 64 + cc * 2; return st * 1024 + (ob ^ (((ob >> 9) & 1) << 5)); }
__host__ __device__ __forceinline__ void stage_rc(int b, int& R, int& C) { const int st = b / 1024, sb = b % 1024, swz = sb ^ (((sb >> 9) & 1) << 5); R = (st >> 1) * 16 + swz / 64; C = (st & 1) * 32 + (swz % 64) / 2; }
__host__ __device__ __forceinline__ int perm32(int rho) { const int n = rho >> 4, i = rho & 15; return 8 * (i >> 2) + 4 * n + (i & 3); }

__device__ __forceinline__ int lane_id_fresh() { int l; asm volatile("v_mbcnt_lo_u32_b32 %0, -1, 0\n\tv_mbcnt_hi_u32_b32 %0, -1, %0" : "=v"(l)); return l; }
struct Unit { int pm, pn; };
struct Gemm { const bf16_t* A; const bf16_t* Bt; int M, N, K, lda; };

struct StaticOrder {
    int nM, nN, nwg, G, c;
    __host__ __device__ void init(int M, int N, int G_, int c_) { nM = M / BM; nN = N / BM; nwg = nM * nN; G = G_; c = c_; }
    __host__ __device__ bool next(int i, Unit& u) const {
        const long L = (long)i * G + c; if (L >= nwg) return false;
        int wgid = (int)L; { const int q = nwg / NXCD, r = nwg % NXCD, xcd = wgid % NXCD, off = wgid / NXCD; wgid = (xcd < r ? xcd * (q + 1) : r * (q + 1) + (xcd - r) * q) + off; }
        const int nig = WGM * nN, gid = wgid / nig, fm = gid * WGM, gsz = (nM - fm) < WGM ? (nM - fm) : WGM;
        u.pm = fm + ((wgid % nig) % gsz); u.pn = (wgid % nig) / gsz; return true;
    }
    __device__ __forceinline__ void a_ready(const Unit&) const {}
    __device__ __forceinline__ void done(const Unit&) const {}
};

__device__ __forceinline__ unsigned cvt_pk_bf16(float lo, float hi) { unsigned r; asm volatile("v_cvt_pk_bf16_f32 %0, %1, %2" : "=v"(r) : "v"(lo), "v"(hi)); return r; }
template <class Epi, class Sched, bool ALIGN_EPI = false, bool SP2 = false>
__device__ __forceinline__ void gemm_phase(PG8_LAS unsigned char* lds, const Gemm g, const Sched& S, const Epi& E, int wave_in) {
    const int wid = wave_in, lane = lane_id_fresh(), tid = wid * 64 + lane, wr = wid >> 2, wc = wid & 3, fr = lane & 15, fq = lane >> 4;
    const int K = g.K, nt = K / BK;
    unsigned voffA[2], voffB[2];
#pragma unroll
    for (int i = 0; i < 2; ++i) { int R, C; stage_rc(tid * 16 + i * 8192, R, C); const int Rb = Epi::PERM ? ((R & ~31) + perm32(R & 31)) : R;
        voffA[i] = (unsigned)(R * g.lda + C) * 2u; voffB[i] = (unsigned)(Rb * K + C) * 2u; }
    const size_t kstep = (size_t)(BK * 2);
    const size_t hstepA = (size_t)HALF * g.lda * 2, hstepB = (size_t)HALF * K * 2;
    const size_t tstepA = 2 * hstepA, tstepB = 2 * hstepB;
    const unsigned ldsw = (unsigned)wid * 1024u;
    const int aoff = lds_byte(wr * 64 + fr, fq * 8), boff = lds_byte(wc * 32 + fr, fq * 8);
#define PG8_SA(b, h) (((b) * 2 + (h)) * HTB)
#define PG8_SB(b, h) ((4 + (b) * 2 + (h)) * HTB)
#define PG8_STAGE(bufoff, gbase, voff) do { _Pragma("unroll") for (int _i = 0; _i < 2; ++_i) \
        __builtin_amdgcn_global_load_lds((const unsigned*)((const char*)(gbase) + (voff)[_i]), (PG8_LAS unsigned*)(lds + (bufoff) + ldsw + _i * 8192), 16, 0, 0); } while (0)
#define PG8_LDA(dst, b, h) do { _Pragma("unroll") for (int m = 0; m < 4; ++m) _Pragma("unroll") for (int k = 0; k < 2; ++k) dst[m][k] = *(const PG8_LAS bf16x8*)(lds + PG8_SA(b, h) + aoff + m * 2048 + k * 1024); } while (0)
#define PG8_LDB(dst, b, h) do { _Pragma("unroll") for (int n = 0; n < 2; ++n) _Pragma("unroll") for (int k = 0; k < 2; ++k) dst[n][k] = *(const PG8_LAS bf16x8*)(lds + PG8_SB(b, h) + boff + n * 2048 + k * 1024); } while (0)
#define PG8_MMA(ai, bj, At, Bt) do { __builtin_amdgcn_s_setprio(1); _Pragma("unroll") for (int m = 0; m < 4; ++m) _Pragma("unroll") for (int n = 0; n < 2; ++n) _Pragma("unroll") for (int k = 0; k < 2; ++k) \
        acc[ai][bj][m][n] = __builtin_amdgcn_mfma_f32_16x16x32_bf16(Bt[n][k], At[m][k], acc[ai][bj][m][n], 0, 0, 0); __builtin_amdgcn_s_setprio(0); } while (0)
#define PG8_WAIT_V(n) asm volatile("s_waitcnt vmcnt(" #n ")" ::: "memory")
#define PG8_WAIT_L(n) asm volatile("s_waitcnt lgkmcnt(" #n ")" ::: "memory")
#define PG8_BAR __builtin_amdgcn_s_barrier()
#define PG8_SCHED __builtin_amdgcn_sched_barrier(0)
    Unit cur, nxt; int ui = 0;
    if (!S.next(0, cur)) return;
    f32x4 acc[2][2][4][2];
#pragma unroll
    for (int a = 0; a < 2; ++a)
#pragma unroll
        for (int b = 0; b < 2; ++b)
#pragma unroll
            for (int m = 0; m < 4; ++m)
#pragma unroll
                for (int n = 0; n < 2; ++n) acc[a][b][m][n] = (f32x4){0.f, 0.f, 0.f, 0.f};
    bf16x8 At[4][2], B0[2][2], B1[2][2];
    const char* cA = (const char*)g.A + (size_t)cur.pm * tstepA; const char* cB = (const char*)g.Bt + (size_t)cur.pn * tstepB;
    S.a_ready(cur);
    if constexpr (SP2) {
        PG8_STAGE(PG8_SB(0, 0), cB, voffB); PG8_STAGE(PG8_SB(0, 1), cB + hstepB, voffB); PG8_STAGE(PG8_SA(0, 0), cA, voffA); PG8_STAGE(PG8_SA(0, 1), cA + hstepA, voffA);
        if (wr == 1) PG8_BAR;
        PG8_WAIT_V(2); PG8_BAR;
        PG8_STAGE(PG8_SB(1, 0), cB + kstep, voffB); PG8_STAGE(PG8_SA(1, 0), cA + kstep, voffA); PG8_STAGE(PG8_SB(1, 1), cB + hstepB + kstep, voffB);
        PG8_WAIT_V(6); PG8_BAR;
    } else {
        PG8_STAGE(PG8_SB(0, 0), cB, voffB); PG8_STAGE(PG8_SA(0, 0), cA, voffA); PG8_STAGE(PG8_SB(0, 1), cB + hstepB, voffB); PG8_STAGE(PG8_SA(0, 1), cA + hstepA, voffA);
        if (wr == 1) PG8_BAR;
        PG8_WAIT_V(4); PG8_BAR;
        PG8_STAGE(PG8_SB(1, 0), cB + kstep, voffB); PG8_STAGE(PG8_SA(1, 0), cA + kstep, voffA); PG8_STAGE(PG8_SB(1, 1), cB + hstepB + kstep, voffB);
        PG8_WAIT_V(6); PG8_BAR;
    }
    for (;;) {
        const bool has_next = S.next(ui + 1, nxt);
        const char* nA = has_next ? (const char*)g.A + (size_t)nxt.pm * tstepA : cA; const char* nB = has_next ? (const char*)g.Bt + (size_t)nxt.pn * tstepB : cB;
        for (int t = 0; t < nt; t += 2) {
            const bool last = (t == nt - 2);
            const char* a1 = cA + (size_t)(t + 1) * kstep;
            const char* a2 = last ? nA : cA + (size_t)(t + 2) * kstep; const char* b2 = last ? nB : cB + (size_t)(t + 2) * kstep;
            const char* a3 = a2 + kstep; const char* b3 = b2 + kstep;
            if (last && has_next) S.a_ready(nxt);
            if constexpr (SP2) {
            PG8_LDB(B0, 0, 0); PG8_LDB(B1, 0, 1); PG8_SCHED; PG8_LDA(At, 0, 0); PG8_STAGE(PG8_SA(1, 1), a1 + hstepA, voffA);
            PG8_WAIT_V(8); PG8_WAIT_L(0); PG8_BAR; PG8_MMA(0, 0, At, B0); PG8_MMA(0, 1, At, B1); PG8_BAR; PG8_SCHED;
            PG8_LDA(At, 0, 1); PG8_STAGE(PG8_SB(0, 0), b2, voffB); PG8_STAGE(PG8_SB(0, 1), b2 + hstepB, voffB); PG8_STAGE(PG8_SA(0, 0), a2, voffA);
            PG8_WAIT_V(8); PG8_WAIT_L(0); PG8_BAR; PG8_MMA(1, 0, At, B0); PG8_MMA(1, 1, At, B1); PG8_BAR; PG8_SCHED;
            PG8_LDB(B0, 1, 0); PG8_LDB(B1, 1, 1); PG8_SCHED; PG8_LDA(At, 1, 0); PG8_STAGE(PG8_SA(0, 1), a2 + hstepA, voffA);
            PG8_WAIT_V(8); PG8_WAIT_L(0); PG8_BAR; PG8_MMA(0, 0, At, B0); PG8_MMA(0, 1, At, B1); PG8_BAR; PG8_SCHED;
            PG8_LDA(At, 1, 1); PG8_STAGE(PG8_SB(1, 0), b3, voffB); PG8_STAGE(PG8_SB(1, 1), b3 + hstepB, voffB); PG8_STAGE(PG8_SA(1, 0), a3, voffA);
            PG8_WAIT_V(8); PG8_WAIT_L(0); PG8_BAR; PG8_MMA(1, 0, At, B0); PG8_MMA(1, 1, At, B1); PG8_BAR; PG8_SCHED;
            } else {
            PG8_LDB(B0, 0, 0); PG8_SCHED; PG8_LDA(At, 0, 0); PG8_STAGE(PG8_SA(1, 1), a1 + hstepA, voffA);
            PG8_WAIT_L(8); PG8_BAR; PG8_WAIT_L(0); PG8_MMA(0, 0, At, B0); PG8_BAR; PG8_SCHED;
            PG8_LDB(B1, 0, 1); PG8_STAGE(PG8_SB(0, 0), b2, voffB);
            PG8_BAR; PG8_WAIT_L(0); PG8_MMA(0, 1, At, B1); PG8_BAR;
            PG8_LDA(At, 0, 1); PG8_STAGE(PG8_SA(0, 0), a2, voffA);
            PG8_BAR; PG8_WAIT_L(0); PG8_MMA(1, 0, At, B0); PG8_BAR; PG8_SCHED;
            PG8_STAGE(PG8_SB(0, 1), b2 + hstepB, voffB);
            PG8_WAIT_V(6); PG8_BAR; PG8_MMA(1, 1, At, B1); PG8_BAR;
            PG8_LDB(B0, 1, 0); PG8_SCHED; PG8_LDA(At, 1, 0); PG8_STAGE(PG8_SA(0, 1), a2 + hstepA, voffA);
            PG8_WAIT_L(8); PG8_BAR; PG8_WAIT_L(0); PG8_MMA(0, 0, At, B0); PG8_BAR; PG8_SCHED;
            PG8_LDB(B1, 1, 1); PG8_STAGE(PG8_SB(1, 0), b3, voffB);
            PG8_BAR; PG8_WAIT_L(0); PG8_MMA(0, 1, At, B1); PG8_BAR;
            PG8_LDA(At, 1, 1); PG8_STAGE(PG8_SA(1, 0), a3, voffA);
            PG8_BAR; PG8_WAIT_L(0); PG8_MMA(1, 0, At, B0); PG8_BAR; PG8_SCHED;
            PG8_STAGE(PG8_SB(1, 1), b3 + hstepB, voffB);
            PG8_WAIT_V(6); PG8_BAR; PG8_MMA(1, 1, At, B1); PG8_BAR;
            }
        }
        if constexpr (ALIGN_EPI) { if (wr == 0) PG8_BAR; }
        if constexpr (!Epi::AFTER_DRAIN) { E(acc, cur, wr, wc, fr, fq); S.done(cur); }
        if (!has_next) break;
#pragma unroll
        for (int a = 0; a < 2; ++a)
#pragma unroll
            for (int b = 0; b < 2; ++b)
#pragma unroll
                for (int m = 0; m < 4; ++m)
#pragma unroll
                    for (int n = 0; n < 2; ++n) acc[a][b][m][n] = (f32x4){0.f, 0.f, 0.f, 0.f};
        cur = nxt; cA = nA; cB = nB; ++ui;
        if constexpr (ALIGN_EPI) { if (wr == 1) PG8_BAR; }
    }
    PG8_WAIT_V(0);
    if constexpr (!ALIGN_EPI) { if (wr == 0) PG8_BAR; }
    PG8_BAR;
    if constexpr (Epi::AFTER_DRAIN) { E.fused(acc, cur, wr, wc, fr, fq, lds, wid, lane); S.done(cur); }
#undef PG8_SA
#undef PG8_SB
#undef PG8_STAGE
#undef PG8_LDA
#undef PG8_LDB
#undef PG8_MMA
#undef PG8_WAIT_V
#undef PG8_WAIT_L
#undef PG8_BAR
#undef PG8_SCHED
}
}

#define LAS __attribute__((address_space(3)))
typedef unsigned short bf16;
typedef short bf16x8 __attribute__((ext_vector_type(8)));
typedef float f32x4 __attribute__((ext_vector_type(4)));
typedef unsigned u32x4 __attribute__((ext_vector_type(4)));
typedef unsigned u32x2 __attribute__((ext_vector_type(2)));

constexpr int BATCH = 8, SEQ = 4096, T = BATCH * SEQ, D = 1024, INW = 4608, RW = 1792, QW = 2816, FF = 2816, ADAW = 6144;
constexpr int QC_Q = 0, QC_K = 512, QC_V = 640, QC_GA = 768, QC_GB = 1792;
constexpr size_t MiB = 1u << 20;
constexpr size_t WS_WIN = 1 * MiB, WS_WA = 10 * MiB, WS_WB = 11 * MiB, WS_WOUT = 12 * MiB, WS_W13 = 14 * MiB, WS_W2 = 25 * MiB;
constexpr size_t WS_DUT = 31 * MiB, WS_IUT = WS_DUT + 65536, WS_GUT = WS_IUT + 65536;
constexpr size_t WS_ADAP = 32 * MiB, WS_ADA = 35 * MiB, WS_RK = 36 * MiB;
constexpr size_t WS_HBUF = 40 * MiB, WS_QKVG = 104 * MiB, WS_R = 280 * MiB, WS_K = 312 * MiB, WS_V = 344 * MiB, WS_LW = 376 * MiB, WS_YA = 376 * MiB  , WS_MC = 408 * MiB  , WS_PG = 440 * MiB, WS_YB = 472 * MiB, WS_ROPE = 504 * MiB  , WS_SLOT = 506 * MiB  , WS_END = 508 * MiB;
constexpr size_t DO_QG = 0, DO_Y0 = 64 * MiB, DO_RP = 96 * MiB;
constexpr int LDS_BYTES = 147456;
constexpr int KSPLIT = 16;

__device__ __forceinline__ float bf2f(bf16 v) { return __uint_as_float((unsigned)v << 16); }
typedef float f32x2_t __attribute__((ext_vector_type(2))); typedef __bf16 bf16x2_t __attribute__((ext_vector_type(2)));
__device__ __forceinline__ unsigned pk2(float lo, float hi) { f32x2_t v = {lo, hi}; bf16x2_t b = __builtin_convertvector(v, bf16x2_t); return __builtin_bit_cast(unsigned, b); }
__device__ __forceinline__ unsigned f2bf(float f) { return pk2(f, f) & 0xffffu; }
__device__ __forceinline__ float sigmoidf_(float x) { return __builtin_amdgcn_rcpf(1.0f + __expf(-x)); }
template <int CTRL, int ROWMASK> __device__ __forceinline__ float dpp_perm(float v) {
    return __int_as_float(__builtin_amdgcn_update_dpp(0, __float_as_int(v), CTRL, ROWMASK, 0xF, false));
}
__device__ __forceinline__ float wave_sum(float v) {
    v += dpp_perm<0xB1, 0xF>(v);
    v += dpp_perm<0x4E, 0xF>(v);
    v += dpp_perm<0x141, 0xF>(v);
    v += dpp_perm<0x140, 0xF>(v);
    v += dpp_perm<0x142, 0xA>(v);
    v += dpp_perm<0x143, 0xC>(v);
    return __int_as_float(__builtin_amdgcn_readlane(__float_as_int(v), 63));
}
__device__ __forceinline__ float row16_sum(float v) { v += dpp_perm<0xB1, 0xF>(v); v += dpp_perm<0x4E, 0xF>(v); v += dpp_perm<0x141, 0xF>(v); v += dpp_perm<0x140, 0xF>(v); return v; }
__device__ __forceinline__ float row16_max(float v) { v = fmaxf(v, dpp_perm<0xB1, 0xF>(v)); v = fmaxf(v, dpp_perm<0x4E, 0xF>(v)); v = fmaxf(v, dpp_perm<0x141, 0xF>(v)); v = fmaxf(v, dpp_perm<0x140, 0xF>(v)); return v; }
__device__ __forceinline__ float rows4_sum(float v) {
    { auto r = __builtin_amdgcn_permlane32_swap(__float_as_uint(v), __float_as_uint(v), false, false); v = __uint_as_float(r[0]) + __uint_as_float(r[1]); }
    { auto r = __builtin_amdgcn_permlane16_swap(__float_as_uint(v), __float_as_uint(v), false, false); v = __uint_as_float(r[0]) + __uint_as_float(r[1]); }
    return v;
}
#define LDS_WAIT() asm volatile("s_waitcnt lgkmcnt(0)" ::: "memory")
#define LBAR() do { asm volatile("s_waitcnt lgkmcnt(0)" ::: "memory"); __builtin_amdgcn_s_barrier(); asm volatile("" ::: "memory"); } while (0)
__device__ __forceinline__ f32x4 bf4(u32x2 w) { return (f32x4){__uint_as_float(w.x << 16), __uint_as_float(w.x & 0xffff0000u), __uint_as_float(w.y << 16), __uint_as_float(w.y & 0xffff0000u)}; }

using pg8::Unit;
using pg8::cvt_pk_bf16;
constexpr int HALF = 128;

struct EpiProj {
    static constexpr bool PERM = true, AFTER_DRAIN = false;
    bf16* Rb; bf16* Q; const float* gbias;
    __device__ __forceinline__ void operator()(const f32x4 (&acc)[2][2][4][2], const Unit& u, int wr, int wc, int fr, int fq) const {
        const int row0 = u.pm * 256 + wr * 64 + fr; const int colt = u.pn * 256;
        bf16* base; int ldc, c0;
        if (u.pn < 7) { base = Rb; ldc = RW; c0 = colt; } else { base = Q; ldc = QW; c0 = colt - RW; }
        const bool gate = u.pn >= 10;
        const int col0 = c0 + wc * 32 + 8 * fq;
#pragma unroll
        for (int bj = 0; bj < 2; ++bj) {
            f32x4 b0 = (f32x4){0.f, 0.f, 0.f, 0.f}, b1 = b0;
            if (gate) { const float* gp = gbias + (colt - 2560) + bj * HALF + wc * 32 + 8 * fq; b0 = *(const f32x4*)gp; b1 = *(const f32x4*)(gp + 4); }
#pragma unroll
            for (int ai = 0; ai < 2; ++ai)
#pragma unroll
                for (int m = 0; m < 4; ++m) {
                    f32x4 v0 = acc[ai][bj][m][0], v1 = acc[ai][bj][m][1];
                    if (gate) {
                        v0 += b0; v1 += b1;
#pragma unroll
                        for (int i = 0; i < 4; ++i) { v0[i] = sigmoidf_(v0[i]); v1[i] = sigmoidf_(v1[i]); }
                    }
                    u32x4 w; w.x = cvt_pk_bf16(v0[0], v0[1]); w.y = cvt_pk_bf16(v0[2], v0[3]); w.z = cvt_pk_bf16(v1[0], v1[1]); w.w = cvt_pk_bf16(v1[2], v1[3]);
                    *(u32x4*)(base + (size_t)(row0 + ai * HALF + m * 16) * ldc + col0 + bj * HALF) = w;
                }
        }
    }
};

__device__ __forceinline__ void bf8(u32x4 w, f32x4& lo, f32x4& hi) {
    lo = (f32x4){__uint_as_float(w.x << 16), __uint_as_float(w.x & 0xffff0000u), __uint_as_float(w.y << 16), __uint_as_float(w.y & 0xffff0000u)};
    hi = (f32x4){__uint_as_float(w.z << 16), __uint_as_float(w.z & 0xffff0000u), __uint_as_float(w.w << 16), __uint_as_float(w.w & 0xffff0000u)};
}
template <int MODE> struct EpiBranch {
    static constexpr bool PERM = true, AFTER_DRAIN = false;
    const bf16* Q; float* tmp; bf16* merged;
    __device__ __forceinline__ void operator()(const f32x4 (&acc)[2][2][4][2], const Unit& u, int wr, int wc, int fr, int fq) const {
        const int row0 = u.pm * 256 + wr * 64 + fr; const int col0 = u.pn * 256 + wc * 32 + 8 * fq;
#pragma unroll
        for (int ai = 0; ai < 2; ++ai)
#pragma unroll
            for (int m = 0; m < 4; ++m) {
                const size_t row = (size_t)(row0 + ai * HALF + m * 16);
#pragma unroll
                for (int bj = 0; bj < 2; ++bj) {
                    const int col = col0 + bj * HALF;
                    f32x4 g0, g1; bf8(*(const u32x4*)(Q + row * QW + (MODE == 0 ? QC_GA : QC_GB) + col), g0, g1);
                    f32x4 v0 = acc[ai][bj][m][0] * g0, v1 = acc[ai][bj][m][1] * g1;
                    if (MODE == 1) { f32x4 t0, t1; bf8(*(const u32x4*)(merged + row * D + col), t0, t1); v0 += t0; v1 += t1; }
                    u32x4 w; w.x = cvt_pk_bf16(v0[0], v0[1]); w.y = cvt_pk_bf16(v0[2], v0[3]); w.z = cvt_pk_bf16(v1[0], v1[1]); w.w = cvt_pk_bf16(v1[2], v1[3]);
                    *(u32x4*)(merged + row * D + col) = w;
                }
            }
    }
};

struct EpiRes {
    static constexpr bool PERM = false, AFTER_DRAIN = false;
    const float* base; float* out; const float* gate;
    __device__ __forceinline__ void operator()(const f32x4 (&acc)[2][2][4][2], const Unit& u, int wr, int wc, int fr, int fq) const {
        const int row0 = u.pm * 256 + wr * 64 + fr; const int col0 = u.pn * 256 + wc * 32 + 4 * fq;
        const float* gp = gate + (size_t)(u.pm / 16) * ADAW;
#pragma unroll
        for (int bj = 0; bj < 2; ++bj)
#pragma unroll
            for (int n = 0; n < 2; ++n) {
                const int col = col0 + bj * HALF + n * 16;
                const f32x4 g = *(const f32x4*)(gp + col);
#pragma unroll
                for (int ai = 0; ai < 2; ++ai)
#pragma unroll
                    for (int m = 0; m < 4; ++m) {
                        const size_t off = (size_t)(row0 + ai * HALF + m * 16) * D + col;
                        *(f32x4*)(out + off) = *(const f32x4*)(base + off) + g * acc[ai][bj][m][n];
                    }
            }
    }
};


struct EpiResNorm {
    static constexpr bool PERM = true, AFTER_DRAIN = false;
    const float* base; float* out; const float* gate; const float* ada; const float* g2; float* slots; unsigned* cnt; bf16* H2;
    __device__ __forceinline__ void operator()(f32x4 (&acc)[2][2][4][2], const Unit& u, int wr, int wc, int fr, int fq) const {
        const int row0 = u.pm * 256 + wr * 64 + fr; const int col0 = u.pn * 256 + wc * 32 + 8 * fq;
        const int b = u.pm / 16;
#pragma unroll
        for (int bj = 0; bj < 2; ++bj) {
            const int col = col0 + bj * HALF;
            const f32x4 g0 = *(const f32x4*)(gate + (size_t)b * ADAW + col), g1 = *(const f32x4*)(gate + (size_t)b * ADAW + col + 4);
#pragma unroll
            for (int ai = 0; ai < 2; ++ai)
#pragma unroll
                for (int m = 0; m < 4; ++m) {
                    const size_t off = (size_t)(row0 + ai * HALF + m * 16) * D + col;
                    const f32x4 x0 = *(const f32x4*)(base + off) + g0 * acc[ai][bj][m][0], x1 = *(const f32x4*)(base + off + 4) + g1 * acc[ai][bj][m][1];
                    *(f32x4*)(out + off) = x0; *(f32x4*)(out + off + 4) = x1;
                    acc[ai][bj][m][0] = x0; acc[ai][bj][m][1] = x1;
                }
        }
#pragma unroll
        for (int ai = 0; ai < 2; ++ai)
#pragma unroll
            for (int m = 0; m < 4; ++m) {
                float s = 0.f;
#pragma unroll
                for (int bj = 0; bj < 2; ++bj)
#pragma unroll
                    for (int n = 0; n < 2; ++n) { const f32x4 v = acc[ai][bj][m][n]; s += (v[0] * v[0] + v[1] * v[1]) + (v[2] * v[2] + v[3] * v[3]); }
                s = rows4_sum(s);
                if (fq == 0) __hip_atomic_store(slots + (size_t)(row0 + ai * HALF + m * 16) * 16 + u.pn * 4 + wc, s, __ATOMIC_RELAXED, __HIP_MEMORY_SCOPE_AGENT);
            }
        asm volatile("s_waitcnt vmcnt(0)" ::: "memory");
        unsigned* c = cnt + 16 * u.pm;
        if ((fr | fq) == 0) __hip_atomic_fetch_add(c, 1u, __ATOMIC_RELAXED, __HIP_MEMORY_SCOPE_AGENT);
        for (unsigned sp = 0; sp < (1u << 22); ++sp) {
            if ((unsigned)__builtin_amdgcn_readfirstlane((int)__hip_atomic_load(c, __ATOMIC_RELAXED, __HIP_MEMORY_SCOPE_AGENT)) >= 32u) break;
            __builtin_amdgcn_s_sleep(2);
        }
        __builtin_amdgcn_fence(__ATOMIC_ACQUIRE, "agent");
        f32x4 sc[2][2], sh[2][2];
#pragma unroll
        for (int bj = 0; bj < 2; ++bj)
#pragma unroll
            for (int n = 0; n < 2; ++n) {
                const int col = col0 + bj * HALF + n * 4;
                sc[bj][n] = *(const f32x4*)(g2 + col) * (*(const f32x4*)(ada + (size_t)b * ADAW + 4096 + col) + 1.0f);
                sh[bj][n] = *(const f32x4*)(ada + (size_t)b * ADAW + 3072 + col);
            }
#pragma unroll
        for (int ai = 0; ai < 2; ++ai)
#pragma unroll
            for (int m = 0; m < 4; ++m) {
                const size_t row = (size_t)(row0 + ai * HALF + m * 16);
                const unsigned long long* sl = (const unsigned long long*)(slots + row * 16 + fq * 4);
                const unsigned long long w0 = __hip_atomic_load(sl, __ATOMIC_RELAXED, __HIP_MEMORY_SCOPE_AGENT), w1 = __hip_atomic_load(sl + 1, __ATOMIC_RELAXED, __HIP_MEMORY_SCOPE_AGENT);
                float t = (__uint_as_float((unsigned)w0) + __uint_as_float((unsigned)(w0 >> 32))) + (__uint_as_float((unsigned)w1) + __uint_as_float((unsigned)(w1 >> 32)));
                t = rows4_sum(t);
                const float inv = rsqrtf(t * (1.0f / D) + 1e-6f);
#pragma unroll
                for (int bj = 0; bj < 2; ++bj) {
                    const f32x4 o0 = acc[ai][bj][m][0] * inv * sc[bj][0] + sh[bj][0], o1 = acc[ai][bj][m][1] * inv * sc[bj][1] + sh[bj][1];
                    u32x4 w; w.x = cvt_pk_bf16(o0[0], o0[1]); w.y = cvt_pk_bf16(o0[2], o0[3]); w.z = cvt_pk_bf16(o1[0], o1[1]); w.w = cvt_pk_bf16(o1[2], o1[3]);
                    *(u32x4*)(H2 + row * D + col0 + bj * HALF) = w;
                }
            }
    }
};

struct EpiSwiglu {
    static constexpr bool PERM = true, AFTER_DRAIN = false;
    bf16* H;
    __device__ __forceinline__ void operator()(const f32x4 (&acc)[2][2][4][2], const Unit& u, int wr, int wc, int fr, int fq) const {
        const int row0 = u.pm * 256 + wr * 64 + fr; const int col0 = u.pn * 128 + wc * 32 + 8 * fq;
#pragma unroll
        for (int ai = 0; ai < 2; ++ai)
#pragma unroll
            for (int m = 0; m < 4; ++m) {
                float o[8];
#pragma unroll
                for (int n = 0; n < 2; ++n)
#pragma unroll
                    for (int i = 0; i < 4; ++i) { const float a = acc[ai][0][m][n][i], b = acc[ai][1][m][n][i]; o[n * 4 + i] = a * sigmoidf_(a) * b; }
                u32x4 w; w.x = cvt_pk_bf16(o[0], o[1]); w.y = cvt_pk_bf16(o[2], o[3]); w.z = cvt_pk_bf16(o[4], o[5]); w.w = cvt_pk_bf16(o[6], o[7]);
                *(u32x4*)(H + (size_t)(row0 + ai * HALF + m * 16) * FF + col0) = w;
            }
    }
};

__device__ __forceinline__ void transpose_item(const float* __restrict__ W, int K, int N, bf16* WT, int mode, LAS float* scr, int item, int lane) {
    const int nblk = N / 32, kb = item / nblk, nb = item % nblk, k0 = 64 * kb, n0 = 32 * nb;
#pragma unroll 8
    for (int i = 0; i < 32; ++i) { const int kk = 2 * i + (lane >> 5); scr[kk * 33 + (lane & 31)] = W[(size_t)(k0 + kk) * N + n0 + (lane & 31)]; }
    LDS_WAIT();
    const int c = lane & 7;
#pragma unroll
    for (int j = 0; j < 4; ++j) {
        const int nn = (lane >> 3) + 8 * j; const LAS float* s = scr + (8 * c) * 33 + nn;
        u32x4 o; o.x = pk2(s[0 * 33], s[1 * 33]); o.y = pk2(s[2 * 33], s[3 * 33]); o.z = pk2(s[4 * 33], s[5 * 33]); o.w = pk2(s[6 * 33], s[7 * 33]);
        const int n = n0 + nn; const int drow = (mode == 0) ? n : ((n >> 7) * 256 + (mode == 2 ? 128 : 0) + (n & 127));
        *(u32x4*)(WT + (size_t)drow * K + k0 + 8 * c) = o;
    }
    LDS_WAIT();
}

struct P0Args { const float *w_in, *wa, *wb, *wout, *w1, *w3, *w2, *ada_w, *c, *decay_up, *iclr_up, *gate_up; unsigned char* ws; };

__device__ __forceinline__ void phase0(const P0Args& A, LAS unsigned char* lds, int gw, int NGW, int wave, int lane, int gt, int NGT) {
    LAS float* scr = (LAS float*)(lds + wave * 16384);
    constexpr int I_IN = 16 * 144, I_A = 8 * 32, I_O = 16 * 32, I_1 = 16 * 88, I_2 = 44 * 32, I_ADA = KSPLIT * 96;
    constexpr int NITEMS = I_IN + 2 * I_A + I_O + 2 * I_1 + I_2 + I_ADA;
    for (int it = gw; it < NITEMS; it += NGW) {
        int r = it;
        if (r < I_ADA) {
            const int ks = r / 96, cb = r % 96, col = cb * 64 + lane;
            float acc[8];
#pragma unroll
            for (int b = 0; b < 8; ++b) acc[b] = 0.f;
            for (int kk = 0; kk < 64; ++kk) {
                const int k = ks * 64 + kk; const float w = A.ada_w[(size_t)k * ADAW + col];
#pragma unroll
                for (int b = 0; b < 8; ++b) acc[b] += A.c[b * D + k] * w;
            }
            float* adap = (float*)(A.ws + WS_ADAP);
#pragma unroll
            for (int b = 0; b < 8; ++b) adap[(size_t)(ks * 8 + b) * ADAW + col] = acc[b];
            continue;
        }
        r -= I_ADA;
        if (r < I_IN) { transpose_item(A.w_in, D, INW, (bf16*)(A.ws + WS_WIN), 0, scr, r, lane); continue; } r -= I_IN;
        if (r < I_A) { transpose_item(A.wa, 512, D, (bf16*)(A.ws + WS_WA), 0, scr, r, lane); continue; } r -= I_A;
        if (r < I_A) { transpose_item(A.wb, 512, D, (bf16*)(A.ws + WS_WB), 0, scr, r, lane); continue; } r -= I_A;
        if (r < I_O) { transpose_item(A.wout, D, D, (bf16*)(A.ws + WS_WOUT), 0, scr, r, lane); continue; } r -= I_O;
        if (r < I_1) { transpose_item(A.w1, D, FF, (bf16*)(A.ws + WS_W13), 1, scr, r, lane); continue; } r -= I_1;
        if (r < I_1) { transpose_item(A.w3, D, FF, (bf16*)(A.ws + WS_W13), 2, scr, r, lane); continue; } r -= I_1;
        transpose_item(A.w2, FF, D, (bf16*)(A.ws + WS_W2), 0, scr, r, lane);
    }
    bf16* DUT = (bf16*)(A.ws + WS_DUT); bf16* IUT = (bf16*)(A.ws + WS_IUT); bf16* GUT = (bf16*)(A.ws + WS_GUT);
    for (int i = gt; i < 512 * 64; i += NGT) { const int ch = i >> 6, k = i & 63; const int d = ((((ch >> 4) * 2 + (k >> 5)) * 64 + ((k >> 3) & 3) * 16 + (ch & 15)) * 8 + (k & 7));
        DUT[d] = (bf16)f2bf(A.decay_up[k * 512 + ch]); IUT[d] = (bf16)f2bf(A.iclr_up[k * 512 + ch]); }
    for (int i = gt; i < 512 * 128; i += NGT) { const int ch = i >> 7, k = i & 127; const int d = ((((ch >> 4) * 4 + (k >> 5)) * 64 + ((k >> 3) & 3) * 16 + (ch & 15)) * 8 + (k & 7));
        GUT[d] = (bf16)f2bf(A.gate_up[k * 512 + ch]); }
}

template <bool PARTIALS>
__device__ __forceinline__ void norm_mod_phase(const float* X, const float* __restrict__ gain, const float* __restrict__ ada_b, const unsigned char* ws, int shift_off, int scale_off, bf16* H, int gw, int NGW, int lane) {
    const float* adap = (const float*)(ws + WS_ADAP); const float* ada = (const float*)(ws + WS_ADA);
    for (int blk = gw; blk < T / 16; blk += NGW) {
        const int r0 = blk * 16, b = r0 / SEQ;
        f32x4 sc[4], sh[4];
#pragma unroll
        for (int j = 0; j < 4; ++j) {
            const int c = 4 * lane + 256 * j;
            f32x4 s, h;
            if (PARTIALS) {
                s = *(const f32x4*)(ada_b + scale_off + c); h = *(const f32x4*)(ada_b + shift_off + c);
                for (int ks = 0; ks < KSPLIT; ++ks) { const float* p = adap + (size_t)(ks * 8 + b) * ADAW; s += *(const f32x4*)(p + scale_off + c); h += *(const f32x4*)(p + shift_off + c); }
            } else { s = *(const f32x4*)(ada + (size_t)b * ADAW + scale_off + c); h = *(const f32x4*)(ada + (size_t)b * ADAW + shift_off + c); }
            const f32x4 g = *(const f32x4*)(gain + c);
            sc[j] = g * (s + 1.0f); sh[j] = h;
        }
        f32x4 nv[4];
        { const f32x4* xr = (const f32x4*)(X + (size_t)r0 * D) + lane;
#pragma unroll
          for (int j = 0; j < 4; ++j) nv[j] = xr[64 * j]; }
        for (int rr = 0; rr < 16; ++rr) {
            const size_t row = (size_t)(r0 + rr);
            f32x4 v[4]; float ss = 0.f;
#pragma unroll
            for (int j = 0; j < 4; ++j) { v[j] = nv[j]; ss += (v[j].x * v[j].x + v[j].y * v[j].y) + (v[j].z * v[j].z + v[j].w * v[j].w); }
            { const f32x4* xr = (const f32x4*)(X + (size_t)(r0 + ((rr < 15) ? rr + 1 : 15)) * D) + lane;
#pragma unroll
              for (int j = 0; j < 4; ++j) nv[j] = xr[64 * j]; }
            const float inv = rsqrtf(wave_sum(ss) * (1.0f / D) + 1e-6f);
            unsigned long long* o8 = (unsigned long long*)(H + row * D) + lane;
#pragma unroll
            for (int j = 0; j < 4; ++j) {
                const f32x4 o = v[j] * inv * sc[j] + sh[j];
                o8[64 * j] = (unsigned long long)pk2(o.x, o.y) | ((unsigned long long)pk2(o.z, o.w) << 32);
            }
        }
    }
}

#ifndef REP_P3A
#define REP_P3A 1
#endif
struct P3Args { const bf16* Rb; const float *mu, *w0, *a0, *k_a, *r_k; unsigned char* ws; };

__device__ __forceinline__ void phase3(const P3Args& A, unsigned char* lds, int tid, int wave, int lane) {
    constexpr int AST = 264;
    bf16* ACT = (bf16*)lds;
    const bf16* DUT = (const bf16*)(A.ws + WS_DUT); const bf16* IUT = (const bf16*)(A.ws + WS_IUT); const bf16* GUT = (const bf16*)(A.ws + WS_GUT);
    bf16* Rr = (bf16*)(A.ws + WS_R); bf16* Kr = (bf16*)(A.ws + WS_K); bf16* Vr = (bf16*)(A.ws + WS_V);
    bf16* G = (bf16*)(A.ws + WS_HBUF); bf16* AH = (bf16*)(A.ws + WS_HBUF + 32 * MiB);
    float* LW = (float*)(A.ws + WS_LW); float* RK = (float*)(A.ws + WS_RK);
    const int fr0 = lane & 15, fq0 = lane >> 4;
    for (int blk = blockIdx.x; blk < T / 128; blk += gridDim.x) {
        const int t0 = blk * 128, b = t0 / SEQ, s0 = t0 % SEQ;
        __syncthreads();
#pragma unroll 1
        for (int rep = 0; rep < 8 * REP_P3A; ++rep) {
            const int task = tid + (rep & 7) * 512, tok = task >> 5, c8 = (task & 31) * 8, t = t0 + tok;
            const u32x4 pc = *(const u32x4*)(A.Rb + (size_t)t * RW + 1536 + c8);
            u32x4 pp = (u32x4){0u, 0u, 0u, 0u};
            if (t % SEQ) pp = *(const u32x4*)(A.Rb + (size_t)(t - 1) * RW + 1536 + c8);
            const f32x4 m0 = *(const f32x4*)(A.mu + 1536 + c8), m1 = *(const f32x4*)(A.mu + 1536 + c8 + 4);
            const unsigned pcw[4] = {pc.x, pc.y, pc.z, pc.w}, ppw[4] = {pp.x, pp.y, pp.z, pp.w};
            float x[8];
#pragma unroll
            for (int i = 0; i < 4; ++i) {
                const float c_lo = __uint_as_float(pcw[i] << 16), c_hi = __uint_as_float(pcw[i] & 0xffff0000u), p_lo = __uint_as_float(ppw[i] << 16), p_hi = __uint_as_float(ppw[i] & 0xffff0000u);
                const float mlo = (i < 2) ? m0[2 * i] : m1[2 * i - 4], mhi = (i < 2) ? m0[2 * i + 1] : m1[2 * i - 3];
                x[2 * i] = c_lo + (p_lo - c_lo) * mlo; x[2 * i + 1] = c_hi + (p_hi - c_hi) * mhi;
            }
            if (c8 < 64) {
#pragma unroll
                for (int i = 0; i < 8; ++i) { const float e = __expf(-2.0f * fabsf(x[i])); const float th = (1.0f - e) * __builtin_amdgcn_rcpf(1.0f + e); x[i] = copysignf(th, x[i]); }
            } else if (c8 >= 128) {
#pragma unroll
                for (int i = 0; i < 8; ++i) x[i] = sigmoidf_(x[i]);
            }
            *(u32x4*)(ACT + tok * AST + c8) = (u32x4){pk2(x[0], x[1]), pk2(x[2], x[3]), pk2(x[4], x[5]), pk2(x[6], x[7])};
        }
        __syncthreads();
        const size_t hb = ((size_t)(b * 8 + wave) * SEQ + s0) * 64;
        const bf16* __restrict__ Rbr = A.Rb;
        unsigned char* stg = lds + 67584 + wave * 7344;
        u32x4 rowreg[7];
#define P3_ROWLOAD(TT, LN) do { _Pragma("unroll") for (int j = 0; j < 7; ++j) { const int task = (LN) + 64 * j; const int arr = task / 136, rem = task - arr * 136, row = rem >> 3, c16 = rem & 7; \
            const int tq = t0 + (TT) * 16 + row - 1; const bool ok = (task < 408) && !(row == 0 && ((t0 + (TT) * 16) % SEQ) == 0); \
            rowreg[j] = (u32x4){0u, 0u, 0u, 0u}; if (ok) rowreg[j] = *(const u32x4*)(Rbr + (size_t)tq * RW + arr * 512 + wave * 64 + c16 * 8); } } while (0)
        { int zo0; asm volatile("v_mov_b32 %0, 0" : "=v"(zo0)); P3_ROWLOAD(0, lane + zo0); }
#pragma unroll 1
        for (int tt = 0; tt < 8; ++tt) {
            int zo; asm volatile("v_mov_b32 %0, 0" : "=v"(zo));
            const int fr = fr0 + zo, fq = fq0 + zo, ln = lane + zo;
            const int tl = tt * 16 + fr, t = t0 + tl;
#pragma unroll
            for (int j = 0; j < 7; ++j) { const int task = ln + 64 * j; const int arr = task / 136, rem = task - arr * 136, row = rem >> 3, c16 = rem & 7;
                if (task < 408) *(u32x4*)(stg + (arr * 17 + row) * 144 + c16 * 16) = rowreg[j]; }
            LDS_WAIT();
            const bf16* actp = ACT + (tt * 16 + fr) * AST + fq * 8;
            f32x4 lwo[4]; u32x2 ro[4], ko[4], vo[4], aho[4], go[4];
            const f32x4 zz = (f32x4){0.f, 0.f, 0.f, 0.f};
            bf16x8 Wd[2], Wi[2], Wg[4];
#pragma unroll
            for (int ks = 0; ks < 2; ++ks) { Wd[ks] = *(const bf16x8*)(DUT + (((wave * 4 + 0) * 2 + ks) * 64 + ln) * 8); Wi[ks] = *(const bf16x8*)(IUT + (((wave * 4 + 0) * 2 + ks) * 64 + ln) * 8); }
#pragma unroll
            for (int ks = 0; ks < 4; ++ks) Wg[ks] = *(const bf16x8*)(GUT + (((wave * 4 + 0) * 4 + ks) * 64 + ln) * 8);
#pragma unroll
            for (int ct = 0; ct < 4; ++ct) {
                const int c4 = ct * 16 + fq * 4, ch = wave * 64 + c4;
                f32x4 ad = zz, ai = zz, ag = zz;
#pragma unroll
                for (int ks = 0; ks < 2; ++ks) {
                    ad = __builtin_amdgcn_mfma_f32_16x16x32_bf16(Wd[ks], *(const bf16x8*)(actp + ks * 32), ad, 0, 0, 0);
                    ai = __builtin_amdgcn_mfma_f32_16x16x32_bf16(Wi[ks], *(const bf16x8*)(actp + 64 + ks * 32), ai, 0, 0, 0);
                }
#pragma unroll
                for (int ks = 0; ks < 4; ++ks) ag = __builtin_amdgcn_mfma_f32_16x16x32_bf16(Wg[ks], *(const bf16x8*)(actp + 128 + ks * 32), ag, 0, 0, 0);
                if (ct < 3) {
#pragma unroll
                    for (int ks = 0; ks < 2; ++ks) { Wd[ks] = *(const bf16x8*)(DUT + (((wave * 4 + ct + 1) * 2 + ks) * 64 + ln) * 8); Wi[ks] = *(const bf16x8*)(IUT + (((wave * 4 + ct + 1) * 2 + ks) * 64 + ln) * 8); }
#pragma unroll
                    for (int ks = 0; ks < 4; ++ks) Wg[ks] = *(const bf16x8*)(GUT + (((wave * 4 + ct + 1) * 4 + ks) * 64 + ln) * 8);
                }
                const f32x4 w0 = *(const f32x4*)(A.w0 + ch), a0 = *(const f32x4*)(A.a0 + ch), ka = *(const f32x4*)(A.k_a + ch), rk = *(const f32x4*)(A.r_k + ch);
                const f32x4 mur = *(const f32x4*)(A.mu + ch), muk = *(const f32x4*)(A.mu + 512 + ch), muv = *(const f32x4*)(A.mu + 1024 + ch);
                const unsigned char* rs = stg + fr * 144 + c4 * 2;
                const f32x4 r0 = bf4(*(const u32x2*)(rs)), r1 = bf4(*(const u32x2*)(rs + 144));
                const f32x4 k0 = bf4(*(const u32x2*)(rs + 17 * 144)), k1 = bf4(*(const u32x2*)(rs + 18 * 144));
                const f32x4 v0 = bf4(*(const u32x2*)(rs + 34 * 144)), v1 = bf4(*(const u32x2*)(rs + 35 * 144));
                const f32x4 rm = r1 + (r0 - r1) * mur, km = k1 + (k0 - k1) * muk, vm = v1 + (v0 - v1) * muv;
                f32x4 lw, ah;
#pragma unroll
                for (int r = 0; r < 4; ++r) { lw[r] = -0.6065306597f * sigmoidf_(w0[r] + ad[r]); ah[r] = sigmoidf_(a0[r] + ai[r]); }
                const f32x4 kp = km * ((ah - 1.0f) * ka + 1.0f);
                const f32x4 pr3 = rm * kp * rk;
                float rks = (pr3[0] + pr3[1]) + (pr3[2] + pr3[3]);
                rks = rows4_sum(rks);
                if (fq == 0) RK[((size_t)t * 8 + wave) * 4 + ct] = rks;
                lwo[ct] = lw;
                ro[ct] = (u32x2){pk2(rm[0], rm[1]), pk2(rm[2], rm[3])}; ko[ct] = (u32x2){pk2(km[0], km[1]), pk2(km[2], km[3])};
                vo[ct] = (u32x2){pk2(vm[0], vm[1]), pk2(vm[2], vm[3])}; aho[ct] = (u32x2){pk2(ah[0], ah[1]), pk2(ah[2], ah[3])};
                go[ct] = (u32x2){pk2(ag[0], ag[1]), pk2(ag[2], ag[3])};
                asm volatile("" ::: "memory");
            }
            P3_ROWLOAD((tt < 7) ? tt + 1 : 7, ln);
            LDS_WAIT();
            const size_t ob = hb + (size_t)(tt * 16) * 64;
#define P3_STAGE_BF16(ARR, SRC) do { \
                _Pragma("unroll") for (int ct = 0; ct < 4; ++ct) *(u32x2*)(stg + fr * 144 + (ct * 16 + fq * 4) * 2) = SRC[ct]; \
                LDS_WAIT(); \
                _Pragma("unroll") for (int j = 0; j < 2; ++j) { const int tk = (ln >> 3) + 8 * j, c16 = ln & 7; \
                    const u32x4 v = *(const u32x4*)(stg + tk * 144 + c16 * 16); *(u32x4*)(ARR + ob + (size_t)tk * 64 + c16 * 8) = v; } \
                LDS_WAIT(); } while (0)
            P3_STAGE_BF16(Rr, ro); P3_STAGE_BF16(Kr, ko); P3_STAGE_BF16(Vr, vo); P3_STAGE_BF16(AH, aho); P3_STAGE_BF16(G, go);
#undef P3_STAGE_BF16
            {
#pragma unroll
                for (int ct = 0; ct < 4; ++ct) *(f32x4*)(stg + fr * 272 + (ct * 16 + fq * 4) * 4) = lwo[ct];
                LDS_WAIT();
#pragma unroll
                for (int j = 0; j < 4; ++j) { const int tk = (ln >> 4) + 4 * j, c4 = (ln & 15) * 4;
                    const f32x4 v = *(const f32x4*)(stg + tk * 272 + c4 * 4); *(f32x4*)(LW + ob + (size_t)tk * 64 + c4) = v; }
                LDS_WAIT();
            }
        }
#undef P3_ROWLOAD
    }
}

struct PAArgs { const float *k_k, *k_a; unsigned char* ws; unsigned char* dout; };
constexpr int MST = 72;
constexpr int MBYTES = 64 * MST * 2;

__device__ __forceinline__ void mm2(const bf16* A, const bf16* Bt, int ti, int tj0, int fr, int fq, f32x4& c0, f32x4& c1) {
#pragma unroll
    for (int ks = 0; ks < 2; ++ks) {
        const bf16x8 a = *(const bf16x8*)(A + (ti * 16 + fr) * MST + ks * 32 + fq * 8);
        const bf16x8 b0 = *(const bf16x8*)(Bt + (tj0 * 16 + fr) * MST + ks * 32 + fq * 8);
        const bf16x8 b1 = *(const bf16x8*)(Bt + (tj0 * 16 + 16 + fr) * MST + ks * 32 + fq * 8);
        c0 = __builtin_amdgcn_mfma_f32_16x16x32_bf16(a, b0, c0, 0, 0, 0);
        c1 = __builtin_amdgcn_mfma_f32_16x16x32_bf16(a, b1, c1, 0, 0, 0);
    }
}

struct ChunkRaw { float lwv[8]; bf16 rb[8], kb[8], vb[8], ab[8]; };
__device__ __forceinline__ void chunk_load(const PAArgs& A, int item, int wave, int lane, ChunkRaw& R) {
    const bf16* Rr = (const bf16*)(A.ws + WS_R); const bf16* Kr = (const bf16*)(A.ws + WS_K); const bf16* Vr = (const bf16*)(A.ws + WS_V);
    const bf16* AH = (const bf16*)(A.ws + WS_HBUF + 32 * MiB); const float* LW = (const float*)(A.ws + WS_LW);
    const int bh = item >> 6, ck = item & 63;
#pragma unroll
    for (int i = 0; i < 8; ++i) {
        const size_t o = ((size_t)bh * SEQ + ck * 64 + wave * 8 + i) * 64 + lane;
        R.lwv[i] = LW[o]; R.rb[i] = Rr[o]; R.kb[i] = Kr[o]; R.vb[i] = Vr[o]; R.ab[i] = AH[o];
    }
}
__device__ __forceinline__ void chunk_item(const PAArgs& A, unsigned char* lds, int item, int tid, int wave, int lane, const ChunkRaw& RAW) {
    bf16* AT = (bf16*)(lds + 0 * MBYTES); bf16* BT = (bf16*)(lds + 1 * MBYTES); bf16* KT = (bf16*)(lds + 2 * MBYTES); bf16* RT = (bf16*)(lds + 3 * MBYTES);
    bf16* BHT = (bf16*)(lds + 4 * MBYTES); bf16* KHT = (bf16*)(lds + 5 * MBYTES); bf16* VT = (bf16*)(lds + 6 * MBYTES);
    bf16* AAK = (bf16*)(lds + 7 * MBYTES); bf16* ARB = (bf16*)(lds + 8 * MBYTES); bf16* ARK = (bf16*)(lds + 9 * MBYTES);
    bf16* X1T = (bf16*)(lds + 10 * MBYTES); bf16* ZT = (bf16*)(lds + 11 * MBYTES);
    bf16* ATT = (bf16*)(lds + 12 * MBYTES); bf16* AVT = (bf16*)(lds + 13 * MBYTES); bf16* AABb = (bf16*)(lds + 14 * MBYTES);
    float* Dg = (float*)(lds + 15 * MBYTES);
    constexpr int TST = 20; bf16* Tinv = (bf16*)(lds + 15 * MBYTES + 4096);
    float* WCs = (float*)(lds + 15 * MBYTES + 4096 + 2560); float* CUMT = Dg;
    const bf16* Rr = (const bf16*)(A.ws + WS_R); const bf16* Kr = (const bf16*)(A.ws + WS_K); const bf16* Vr = (const bf16*)(A.ws + WS_V);
    const bf16* AH = (const bf16*)(A.ws + WS_HBUF + 32 * MiB); const float* LW = (const float*)(A.ws + WS_LW);
    float* Qg = (float*)(A.dout + DO_QG) + (size_t)item * 4096; bf16* Y0g = (bf16*)(A.dout + DO_Y0) + (size_t)item * 4096;
    bf16* RPg = (bf16*)(A.dout + DO_RP) + (size_t)item * 4096; bf16* Pg = (bf16*)(A.ws + WS_PG) + (size_t)item * 4096;
    const int bh = item >> 6, ck = item & 63, b = bh >> 3, h = bh & 7;
    const size_t tok0 = (size_t)b * SEQ + ck * 64;
    const int fr = lane & 15, fq = lane >> 4;
    LBAR();
    {
        const int ch = lane, tg = wave;
        float lwv[8], rv[8], kv[8], av[8], pl[8]; bf16 vb[8];
        float run = 0.f;
#pragma unroll
        for (int i = 0; i < 8; ++i) {
            lwv[i] = RAW.lwv[i]; rv[i] = bf2f(RAW.rb[i]); kv[i] = bf2f(RAW.kb[i]); vb[i] = RAW.vb[i]; av[i] = bf2f(RAW.ab[i]);
            run += lwv[i]; pl[i] = run;
        }
        CUMT[tg * 64 + ch] = run;
        LBAR();
        float off = 0.f, tot = 0.f;
#pragma unroll
        for (int g = 0; g < 8; ++g) { const float c = CUMT[g * 64 + ch]; tot += c; off += (g < tg) ? c : 0.f; }
        const float kkc = A.k_k[h * 64 + ch], kac = A.k_a[h * 64 + ch];
        const float etot = __expf(tot);
        unsigned bhp[4], khp[4], vp[4];
        float bhv[8], khv[8], atv[8];
#pragma unroll
        for (int i = 0; i < 8; ++i) {
            const float cl = off + pl[i], clp = cl - lwv[i];
            const float kq = kv[i] * kkc;
            const float kk = kq * __builtin_amdgcn_rsqf(fmaxf(wave_sum(kq * kq), 1e-24f));
            const float a_ = -kk, b_ = kk * av[i], kp = kv[i] * (1.0f + (av[i] - 1.0f) * kac);
            const float ecl = __expf(cl), encl = __builtin_amdgcn_rcpf(ecl), eclp = __expf(clp), eh = etot * encl;
            const int tok = tg * 8 + i;
            atv[i] = a_ * eclp; AT[tok * MST + ch] = (bf16)f2bf(a_ * eclp); BT[tok * MST + ch] = (bf16)f2bf(b_ * encl); KT[tok * MST + ch] = (bf16)f2bf(kp * encl); RT[tok * MST + ch] = (bf16)f2bf(rv[i] * ecl);
            bhv[i] = b_ * eh; khv[i] = kp * eh;
        }
#pragma unroll
        for (int i = 0; i < 4; ++i) { bhp[i] = pk2(bhv[2 * i], bhv[2 * i + 1]); khp[i] = pk2(khv[2 * i], khv[2 * i + 1]); vp[i] = (unsigned)vb[2 * i] | ((unsigned)vb[2 * i + 1] << 16); }
        *(u32x4*)(BHT + ch * MST + tg * 8) = (u32x4){bhp[0], bhp[1], bhp[2], bhp[3]};
        *(u32x4*)(KHT + ch * MST + tg * 8) = (u32x4){khp[0], khp[1], khp[2], khp[3]};
        *(u32x4*)(VT + ch * MST + tg * 8) = (u32x4){vp[0], vp[1], vp[2], vp[3]};
        *(u32x4*)(ATT + ch * MST + tg * 8) = (u32x4){pk2(atv[0], atv[1]), pk2(atv[2], atv[3]), pk2(atv[4], atv[5]), pk2(atv[6], atv[7])};
        if (tg == 0) WCs[ch] = etot;
    }
    LBAR();
    const int ti = wave >> 1, tj0 = (wave & 1) * 2;
    const f32x4 z4 = (f32x4){0.f, 0.f, 0.f, 0.f};
    {
        f32x4 c0 = z4, c1 = z4;
        const int jb = ti * 16 + fq * 4;
        const int ta = tj0 * 16 + fr, tb = ta + 16;
#define S3_MASK(c, t, INCL) (f32x4){ (jb + 0 < (t) + (INCL)) ? c[0] : 0.f, (jb + 1 < (t) + (INCL)) ? c[1] : 0.f, (jb + 2 < (t) + (INCL)) ? c[2] : 0.f, (jb + 3 < (t) + (INCL)) ? c[3] : 0.f }
        mm2(BT, AT, ti, tj0, fr, fq, c0, c1);
        { const f32x4 m0 = S3_MASK(c0, ta, 0), m1 = S3_MASK(c1, tb, 0);
          *(u32x2*)(AABb + ta * MST + jb) = (u32x2){pk2(m0[0], m0[1]), pk2(m0[2], m0[3])}; *(u32x2*)(AABb + tb * MST + jb) = (u32x2){pk2(m1[0], m1[1]), pk2(m1[2], m1[3])};
          if (tj0 == ti) *(f32x4*)(Dg + (ti * 16 + fr) * 16 + fq * 4) = m0;
          if (tj0 + 1 == ti) *(f32x4*)(Dg + (ti * 16 + fr) * 16 + fq * 4) = m1; }
        c0 = z4; c1 = z4; mm2(KT, AT, ti, tj0, fr, fq, c0, c1);
        { const f32x4 m0 = S3_MASK(c0, ta, 0), m1 = S3_MASK(c1, tb, 0);
          *(u32x2*)(AAK + ta * MST + jb) = (u32x2){pk2(m0[0], m0[1]), pk2(m0[2], m0[3])}; *(u32x2*)(AAK + tb * MST + jb) = (u32x2){pk2(m1[0], m1[1]), pk2(m1[2], m1[3])}; }
        c0 = z4; c1 = z4; mm2(BT, RT, ti, tj0, fr, fq, c0, c1);
        { const f32x4 m0 = S3_MASK(c0, ta, 1), m1 = S3_MASK(c1, tb, 1);
          *(u32x2*)(ARB + ta * MST + jb) = (u32x2){pk2(m0[0], m0[1]), pk2(m0[2], m0[3])}; *(u32x2*)(ARB + tb * MST + jb) = (u32x2){pk2(m1[0], m1[1]), pk2(m1[2], m1[3])}; }
        c0 = z4; c1 = z4; mm2(KT, RT, ti, tj0, fr, fq, c0, c1);
        { const f32x4 m0 = S3_MASK(c0, ta, 1), m1 = S3_MASK(c1, tb, 1);
          *(u32x2*)(ARK + ta * MST + jb) = (u32x2){pk2(m0[0], m0[1]), pk2(m0[2], m0[3])}; *(u32x2*)(ARK + tb * MST + jb) = (u32x2){pk2(m1[0], m1[1]), pk2(m1[2], m1[3])}; }
#undef S3_MASK
    }
    LBAR();
    {
        f32x4 c0 = z4, c1 = z4;
        mm2(AAK, VT, ti, tj0, fr, fq, c0, c1);
        *(u32x2*)(AVT + (tj0 * 16 + fr) * MST + ti * 16 + fq * 4) = (u32x2){pk2(c0[0], c0[1]), pk2(c0[2], c0[3])};
        *(u32x2*)(AVT + (tj0 * 16 + 16 + fr) * MST + ti * 16 + fq * 4) = (u32x2){pk2(c1[0], c1[1]), pk2(c1[2], c1[3])};
        if (wave == 0) {
            const int bi = lane >> 4, cc = lane & 15;
            float t[16];
#pragma unroll
            for (int r = 0; r < 16; ++r) {
                float acc = (r == cc) ? 1.f : 0.f;
#pragma unroll
                for (int k = 0; k < r; ++k) acc += Dg[(bi * 16 + r) * 16 + k] * t[k];
                t[r] = acc;
            }
#pragma unroll
            for (int r = 0; r < 16; ++r) Tinv[(bi * 16 + r) * TST + cc] = (bf16)f2bf(t[r]);
        }
    }
    LBAR();
    {
        typedef short s16x4 __attribute__((ext_vector_type(4)));
        const int cb = (wave & 3) * 16 + fr;
        const bf16* src = (wave < 4 ? ATT : AVT) + cb * MST;
        bf16* dst = (wave < 4 ? X1T : ZT) + cb * MST;
        s16x4 xb[4];
#pragma unroll
        for (int bi = 0; bi < 4; ++bi) {
            f32x4 acc = bf4(*(const u32x2*)(src + bi * 16 + fq * 4));
#pragma unroll
            for (int bj = 0; bj < bi; ++bj) acc = __builtin_amdgcn_mfma_f32_16x16x16bf16_1k(*(const s16x4*)(AABb + (bi * 16 + fr) * MST + bj * 16 + fq * 4), xb[bj], acc, 0, 0, 0);
            const u32x2 tb = (u32x2){pk2(acc[0], acc[1]), pk2(acc[2], acc[3])};
            const f32x4 xv = __builtin_amdgcn_mfma_f32_16x16x16bf16_1k(*(const s16x4*)(Tinv + (bi * 16 + fr) * TST + fq * 4), __builtin_bit_cast(s16x4, tb), z4, 0, 0, 0);
            const u32x2 xw = (u32x2){pk2(xv[0], xv[1]), pk2(xv[2], xv[3])};
            xb[bi] = __builtin_bit_cast(s16x4, xw);
            *(u32x2*)(dst + bi * 16 + fq * 4) = xw;
        }
    }
    LBAR();
    {
        f32x4 c0, c1;
        const int fl = lane * 4;
        { const u32x2 w0 = *(const u32x2*)(RT + (tj0 * 16 + fr) * MST + ti * 16 + fq * 4), w1 = *(const u32x2*)(RT + (tj0 * 16 + 16 + fr) * MST + ti * 16 + fq * 4);
          c0 = (f32x4){__uint_as_float(w0.x << 16), __uint_as_float(w0.x & 0xffff0000u), __uint_as_float(w0.y << 16), __uint_as_float(w0.y & 0xffff0000u)};
          c1 = (f32x4){__uint_as_float(w1.x << 16), __uint_as_float(w1.x & 0xffff0000u), __uint_as_float(w1.y << 16), __uint_as_float(w1.y & 0xffff0000u)}; }
        mm2(X1T, ARB, ti, tj0, fr, fq, c0, c1);
        const int fpos = (((ti >> 1) * 64) + ((ti & 1) * 2 + (fq >> 1)) * 16 + fr) * 8 + (fq & 1) * 4;
        *(u32x2*)(RPg + tj0 * 1024 + fpos) = (u32x2){pk2(c0[0], c0[1]), pk2(c0[2], c0[3])};
        *(u32x2*)(RPg + (tj0 + 1) * 1024 + fpos) = (u32x2){pk2(c1[0], c1[1]), pk2(c1[2], c1[3])};
        c0 = z4; c1 = z4; mm2(ZT, ARB, ti, tj0, fr, fq, c0, c1); mm2(VT, ARK, ti, tj0, fr, fq, c0, c1);
        *(u32x2*)(Y0g + (ti * 4 + tj0) * 256 + fl) = (u32x2){pk2(c0[0], c0[1]), pk2(c0[2], c0[3])};
        *(u32x2*)(Y0g + (ti * 4 + tj0 + 1) * 256 + fl) = (u32x2){pk2(c1[0], c1[1]), pk2(c1[2], c1[3])};
        c0 = z4; c1 = z4; mm2(X1T, BHT, ti, tj0, fr, fq, c0, c1);
        { const int chp = ti * 16 + fq * 4, cha = tj0 * 16 + fr, chb = cha + 16; const float wa = WCs[cha], wb = WCs[chb];
#pragma unroll
          for (int r = 0; r < 4; ++r) { c0[r] += (chp + r == cha) ? wa : 0.f; c1[r] += (chp + r == chb) ? wb : 0.f; }
          *(u32x2*)(Pg + tj0 * 1024 + fpos) = (u32x2){pk2(c0[0], c0[1]), pk2(c0[2], c0[3])};
          *(u32x2*)(Pg + (tj0 + 1) * 1024 + fpos) = (u32x2){pk2(c1[0], c1[1]), pk2(c1[2], c1[3])}; }
        c0 = z4; c1 = z4; mm2(BHT, ZT, ti, tj0, fr, fq, c0, c1); mm2(KHT, VT, ti, tj0, fr, fq, c0, c1);
        *(f32x4*)(Qg + (ti * 4 + tj0) * 256 + fl) = c0;
        *(f32x4*)(Qg + (ti * 4 + tj0 + 1) * 256 + fl) = c1;
    }
}

struct PBArgs { const float *lnx_g, *lnx_b; unsigned char* ws; unsigned char* dout; };

__device__ __forceinline__ void chunk_scan_m(const PBArgs& A, unsigned char* lds, int bh, int tid, int wave, int lane) {
    const float* Qg = (const float*)(A.dout + DO_QG); const bf16* Pg = (const bf16*)(A.ws + WS_PG);
    bf16* MC = (bf16*)(A.ws + WS_MC);
    const int fr = lane & 15, fq = lane >> 4, ti = wave >> 1, vj0 = (wave & 1) * 2;
    for (int i = tid; i < 64 * MST; i += 512) ((bf16*)lds)[i] = 0;
    const size_t item0 = (size_t)bh * 64;
    for (int i = tid; i < 512; i += 512) *(u32x4*)(MC + item0 * 4096 + (size_t)i * 8) = (u32x4){0u, 0u, 0u, 0u};
    LBAR();
    constexpr int PF = 4;
    bf16x8 aS[PF][2]; f32x4 cS[PF][2];
#pragma unroll
    for (int s = 0; s < PF; ++s) {
        const size_t it = (item0 + s) * 4096;
#pragma unroll
        for (int ks = 0; ks < 2; ++ks) aS[s][ks] = *(const bf16x8*)(Pg + it + ((ti * 2 + ks) * 64 + lane) * 8);
#pragma unroll
        for (int j = 0; j < 2; ++j) cS[s][j] = *(const f32x4*)(Qg + it + (ti * 4 + vj0 + j) * 256 + lane * 4);
    }
    const int fks = ti >> 1, ffq = (ti & 1) * 2 + (fq >> 1), fhalf = fq & 1;
    for (int ck0 = 0; ck0 < 64; ck0 += PF) {
#pragma unroll
        for (int s = 0; s < PF; ++s) {
            const int ck = ck0 + s;
            const bf16* cur = (const bf16*)(lds + (ck & 1) * MBYTES); bf16* nxt = (bf16*)(lds + ((ck + 1) & 1) * MBYTES);
            f32x4 c[2];
#pragma unroll
            for (int j = 0; j < 2; ++j) {
                c[j] = cS[s][j];
#pragma unroll
                for (int ks = 0; ks < 2; ++ks) c[j] = __builtin_amdgcn_mfma_f32_16x16x32_bf16(aS[s][ks], *(const bf16x8*)(cur + ((vj0 + j) * 16 + fr) * MST + ks * 32 + fq * 8), c[j], 0, 0, 0);
            }
            {
                const int ckn = (ck + PF < 64) ? ck + PF : 63;
                const size_t it = (item0 + ckn) * 4096;
#pragma unroll
                for (int ks = 0; ks < 2; ++ks) aS[s][ks] = *(const bf16x8*)(Pg + it + ((ti * 2 + ks) * 64 + lane) * 8);
#pragma unroll
                for (int j = 0; j < 2; ++j) cS[s][j] = *(const f32x4*)(Qg + it + (ti * 4 + vj0 + j) * 256 + lane * 4);
            }
#pragma unroll
            for (int j = 0; j < 2; ++j) {
                const u32x2 w = (u32x2){pk2(c[j][0], c[j][1]), pk2(c[j][2], c[j][3])};
                *(u32x2*)(nxt + ((vj0 + j) * 16 + fr) * MST + ti * 16 + fq * 4) = w;
                if (ck < 63) *(u32x2*)(MC + (item0 + ck + 1) * 4096 + ((((vj0 + j) * 2 + fks) * 64 + ffq * 16 + fr) * 8 + fhalf * 4)) = w;
            }
            LBAR();
        }
    }
}

__device__ __forceinline__ void chunk_out(const PBArgs& A, unsigned char* lds, int G_, int wave, int lane) {
    const bf16* Y0g = (const bf16*)(A.dout + DO_Y0); const bf16* RPg = (const bf16*)(A.dout + DO_RP); const bf16* MC = (const bf16*)(A.ws + WS_MC);
    const bf16* Vr = (const bf16*)(A.ws + WS_V); const bf16* Gt = (const bf16*)(A.ws + WS_HBUF); const float* RK = (const float*)(A.ws + WS_RK);
    bf16* YA = (bf16*)(A.ws + WS_YA);
    const int fr = lane & 15, fq = lane >> 4, tt = wave & 3, half = wave >> 2;
    unsigned char* ostg = lds + wave * 2304;
    bf16x8 nbR[2], naM[4][2]; u32x2 ny0[4]; u32x4 nrv[2], nrg[2]; f32x4 nr4;
#define CO_LOAD(IT) do { const int it_ = (IT); const int bh_ = it_ >> 6, ck_ = it_ & 63; const size_t ib_ = (size_t)it_ * 4096; \
        _Pragma("unroll") for (int ks = 0; ks < 2; ++ks) nbR[ks] = *(const bf16x8*)(RPg + ib_ + ((tt * 2 + ks) * 64 + lane) * 8); \
        _Pragma("unroll") for (int vi = 0; vi < 4; ++vi) { _Pragma("unroll") for (int ks = 0; ks < 2; ++ks) naM[vi][ks] = *(const bf16x8*)(MC + ib_ + ((vi * 2 + ks) * 64 + lane) * 8); \
            ny0[vi] = *(const u32x2*)(Y0g + ib_ + (vi * 4 + tt) * 256 + lane * 4); } \
        const size_t rbase_ = ((size_t)bh_ * SEQ + ck_ * 64 + tt * 16) * 64; \
        _Pragma("unroll") for (int j = 0; j < 2; ++j) { const int tk = (lane >> 3) + 8 * j, c16 = lane & 7; nrv[j] = *(const u32x4*)(Vr + rbase_ + (size_t)tk * 64 + c16 * 8); nrg[j] = *(const u32x4*)(Gt + rbase_ + (size_t)tk * 64 + c16 * 8); } \
        nr4 = *(const f32x4*)(RK + ((((size_t)(bh_ >> 3) * SEQ + ck_ * 64 + tt * 16 + fr) * 8 + (bh_ & 7)) * 4)); } while (0)
    const int it0 = blockIdx.x * 2 + half;
    if (it0 < 4096) CO_LOAD(it0);
    for (int it = it0; it < 4096; it += 2 * G_) {
        const int bh = it >> 6, ck = it & 63, b = bh >> 3, h = bh & 7;
        bf16x8 bR[2], aM[4][2]; u32x2 y0[4], vv[4], gg[4]; u32x4 rv[2], rg[2];
#pragma unroll
        for (int ks = 0; ks < 2; ++ks) bR[ks] = nbR[ks];
#pragma unroll
        for (int vi = 0; vi < 4; ++vi) { aM[vi][0] = naM[vi][0]; aM[vi][1] = naM[vi][1]; y0[vi] = ny0[vi]; }
#pragma unroll
        for (int j = 0; j < 2; ++j) { rv[j] = nrv[j]; rg[j] = nrg[j]; }
        const float rk = (nr4[0] + nr4[1]) + (nr4[2] + nr4[3]);
        {
#pragma unroll
            for (int j = 0; j < 2; ++j) { const int tk = (lane >> 3) + 8 * j, c16 = lane & 7; *(u32x4*)(ostg + tk * 144 + c16 * 16) = rv[j]; }
            LDS_WAIT();
#pragma unroll
            for (int vi = 0; vi < 4; ++vi) vv[vi] = *(const u32x2*)(ostg + fr * 144 + (vi * 16 + fq * 4) * 2);
            LDS_WAIT();
#pragma unroll
            for (int j = 0; j < 2; ++j) { const int tk = (lane >> 3) + 8 * j, c16 = lane & 7; *(u32x4*)(ostg + tk * 144 + c16 * 16) = rg[j]; }
            LDS_WAIT();
#pragma unroll
            for (int vi = 0; vi < 4; ++vi) gg[vi] = *(const u32x2*)(ostg + fr * 144 + (vi * 16 + fq * 4) * 2);
            LDS_WAIT();
        }
        f32x4 c[4];
#pragma unroll
        for (int vi = 0; vi < 4; ++vi) {
            c[vi] = bf4(y0[vi]);
#pragma unroll
            for (int ks = 0; ks < 2; ++ks) c[vi] = __builtin_amdgcn_mfma_f32_16x16x32_bf16(aM[vi][ks], bR[ks], c[vi], 0, 0, 0);
        }
        { const int itn = (it + 2 * G_ < 4096) ? it + 2 * G_ : it; CO_LOAD(itn); }
        float sm = 0.f;
#pragma unroll
        for (int vi = 0; vi < 4; ++vi) sm += (c[vi][0] + c[vi][1]) + (c[vi][2] + c[vi][3]);
        sm = rows4_sum(sm);
        const float mu = sm * (1.0f / 64.0f);
        float q = 0.f;
#pragma unroll
        for (int vi = 0; vi < 4; ++vi) { c[vi] = c[vi] - mu; q += (c[vi][0] * c[vi][0] + c[vi][1] * c[vi][1]) + (c[vi][2] * c[vi][2] + c[vi][3] * c[vi][3]); }
        q = rows4_sum(q);
        const float rs = rsqrtf(q * (1.0f / 64.0f) + 64e-5f);
#pragma unroll
        for (int vi = 0; vi < 4; ++vi) {
            const f32x4 lg = *(const f32x4*)(A.lnx_g + h * 64 + vi * 16 + fq * 4), lb = *(const f32x4*)(A.lnx_b + h * 64 + vi * 16 + fq * 4);
            const f32x4 o = (c[vi] * rs * lg + lb + bf4(vv[vi]) * rk) * bf4(gg[vi]);
            *(u32x2*)(ostg + fr * 144 + (vi * 16 + fq * 4) * 2) = (u32x2){pk2(o[0], o[1]), pk2(o[2], o[3])};
        }
        LDS_WAIT();
#pragma unroll
        for (int j = 0; j < 2; ++j) {
            const int tk = (lane >> 3) + 8 * j, c16 = lane & 7;
            const size_t tg = (size_t)b * SEQ + ck * 64 + tt * 16 + tk;
            *(u32x4*)(YA + tg * 512 + h * 64 + c16 * 8) = *(const u32x4*)(ostg + tk * 144 + c16 * 16);
        }
        LDS_WAIT();
    }
#undef CO_LOAD
}

struct AtArgs { const float *qg, *kg, *sinks; const int* pos; unsigned char* ws; };

__device__ __forceinline__ void rope_entry(int pos, int j, float& cs, float& sn) {
    const double fr[8] = {0.15915494309189535, 0.03086376340470123, 0.005985185712713705, 0.001160663641240061, 0.00022507907903927653, 4.364795279280289e-05, 8.464330808241401e-06, 1.6414262627950345e-06};
    double f0 = fr[0];
#pragma unroll
    for (int i = 1; i < 8; ++i) f0 = (j == i) ? fr[i] : f0;
    const double tt = (double)pos * f0;
    const float f = (float)(tt - __builtin_floor(tt));
    sn = __builtin_amdgcn_sinf(f); cs = __builtin_amdgcn_cosf(f);
}
__device__ __forceinline__ void rope16(float* x, const float* rp) {
    const f32x4 c0 = *(const f32x4*)rp, c1 = *(const f32x4*)(rp + 4), s0 = *(const f32x4*)(rp + 8), s1 = *(const f32x4*)(rp + 12);
#pragma unroll
    for (int i = 0; i < 8; ++i) {
        const float cs = (i < 4) ? c0[i & 3] : c1[i & 3], sn = (i < 4) ? s0[i & 3] : s1[i & 3];
        const float x1 = x[i], x2 = x[8 + i];
        x[i] = x1 * cs - x2 * sn; x[8 + i] = x2 * cs + x1 * sn;
    }
}
__device__ __forceinline__ void norm_rope(u32x4 w0, u32x4 w1, const float* __restrict__ gain, int chunk, const float* rp, float scale, float* x) {
    const unsigned ww[8] = {w0.x, w0.y, w0.z, w0.w, w1.x, w1.y, w1.z, w1.w};
    float ss = 0.f;
#pragma unroll
    for (int i = 0; i < 8; ++i) { x[2 * i] = __uint_as_float(ww[i] << 16); x[2 * i + 1] = __uint_as_float(ww[i] & 0xffff0000u); ss += x[2 * i] * x[2 * i] + x[2 * i + 1] * x[2 * i + 1]; }
    ss += dpp_perm<0xB1, 0xF>(ss); ss += dpp_perm<0x4E, 0xF>(ss);
    const float inv = rsqrtf(ss * (1.0f / 64.0f) + 1e-6f);
#pragma unroll
    for (int i = 0; i < 16; ++i) x[i] = x[i] * inv * gain[chunk * 16 + i];
    if (chunk == 0) rope16(x, rp);
#pragma unroll
    for (int i = 0; i < 16; ++i) x[i] *= scale;
}
__device__ __forceinline__ void load_norm_rope(const bf16* p, bool valid, const float* __restrict__ gain, int chunk, const float* rp, float scale, float* x) {
    u32x4 w0 = (u32x4){0, 0, 0, 0}, w1 = w0;
    if (valid) { w0 = *(const u32x4*)p; w1 = *(const u32x4*)(p + 8); }
    norm_rope(w0, w1, gain, chunk, rp, scale, x);
}

__device__ __forceinline__ void attn_unit(const AtArgs& A, unsigned char* lds, int unit, int tid, int wave, int lane) {
    constexpr int KST = 72, VST = 280, PST = 168, QST = 72;
    bf16* KS = (bf16*)lds;
    bf16* VT = (bf16*)(lds + 36864);
    bf16* PS = (bf16*)(lds + 36864 + 35840) + wave * 16 * PST;
    bf16* QS = (bf16*)(lds + 36864 + 35840 + 8 * 16 * PST * 2) + wave * 16 * QST;
    const bf16* Q = (const bf16*)(A.ws + WS_QKVG); bf16* YB = (bf16*)(A.ws + WS_YB);
    const int b = unit >> 6, kvh = (unit >> 5) & 1, nb = unit & 31;
    const int fr = lane & 15, fq = lane >> 4;
    const float* ROPE = (const float*)(A.ws + WS_ROPE);
    u32x4 qn0, qn1;
    const bf16* pq0;
    {
        const int g_ = wave >> 1, qh_ = wave & 1, hq_ = kvh * 4 + g_, row = lane >> 2, chunk = lane & 3;
        const size_t t = (size_t)b * SEQ + nb * 128 + qh_ * 64 + row;
        pq0 = Q + t * QW + QC_Q + hq_ * 64 + chunk * 16;
        qn0 = *(const u32x4*)pq0; qn1 = *(const u32x4*)(pq0 + 8);
    }
    LBAR();
#pragma unroll
    for (int rep = 0; rep < 2; ++rep) {
        const int task = tid + rep * 512, key = task >> 2, chunk = task & 3;
        const int s = (nb - 1) * 128 + key; const bool valid = s >= 0;
        const size_t t = (size_t)b * SEQ + (valid ? s : 0);
        float x[16];
        load_norm_rope(Q + t * QW + QC_K + kvh * 64 + chunk * 16, valid, A.kg, chunk, ROPE + t * 16, 1.0f, x);
        u32x4 o0, o1; o0.x = pk2(x[0], x[1]); o0.y = pk2(x[2], x[3]); o0.z = pk2(x[4], x[5]); o0.w = pk2(x[6], x[7]); o1.x = pk2(x[8], x[9]); o1.y = pk2(x[10], x[11]); o1.z = pk2(x[12], x[13]); o1.w = pk2(x[14], x[15]);
        *(u32x4*)(KS + key * KST + chunk * 16) = o0; *(u32x4*)(KS + key * KST + chunk * 16 + 8) = o1;
    }
#pragma unroll
    for (int rep = 0; rep < 4; ++rep) {
        const int task = tid + rep * 512, key = task >> 3, c8 = task & 7;
        const int s = (nb - 1) * 128 + key; const bool valid = s >= 0;
        const size_t t = (size_t)b * SEQ + (valid ? s : 0);
        u32x4 w = (u32x4){0, 0, 0, 0};
        if (valid) w = *(const u32x4*)(Q + t * QW + QC_V + kvh * 64 + c8 * 8);
        const unsigned ww[4] = {w.x, w.y, w.z, w.w};
#pragma unroll
        for (int i = 0; i < 4; ++i) { VT[(c8 * 8 + 2 * i) * VST + key] = (bf16)(ww[i] & 0xffffu); VT[(c8 * 8 + 2 * i + 1) * VST + key] = (bf16)(ww[i] >> 16); }
    }
    for (int i = tid; i < 64 * 24; i += 512) VT[(i / 24) * VST + 256 + (i % 24)] = 0;
    LBAR();
    const int g = wave >> 1, qh = wave & 1, hq = kvh * 4 + g;
    const float sink = A.sinks[hq];
#pragma unroll 1
    for (int st = 0; st < 4; ++st) {
        const int q0 = qh * 64 + st * 16;
        {
            const int row = lane >> 2, chunk = lane & 3;
            const size_t t = (size_t)b * SEQ + nb * 128 + q0 + row;
            float x[16];
            const u32x4 qc0 = qn0, qc1 = qn1;
            { const bf16* pn = pq0 + (size_t)((st < 3) ? st + 1 : 3) * 16 * QW; qn0 = *(const u32x4*)pn; qn1 = *(const u32x4*)(pn + 8); }
            norm_rope(qc0, qc1, A.qg, chunk, ROPE + t * 16, 0.125f, x);
            u32x4 o0, o1; o0.x = pk2(x[0], x[1]); o0.y = pk2(x[2], x[3]); o0.z = pk2(x[4], x[5]); o0.w = pk2(x[6], x[7]); o1.x = pk2(x[8], x[9]); o1.y = pk2(x[10], x[11]); o1.z = pk2(x[12], x[13]); o1.w = pk2(x[14], x[15]);
            *(u32x4*)(QS + row * QST + chunk * 16) = o0; *(u32x4*)(QS + row * QST + chunk * 16 + 8) = o1;
        }
        LDS_WAIT();
        const bf16x8 qa0 = *(const bf16x8*)(QS + fr * QST + fq * 8), qa1 = *(const bf16x8*)(QS + fr * QST + 32 + fq * 8);
        f32x4 sc[9];
#pragma unroll
        for (int kt = 0; kt < 9; ++kt) {
            const int key = (q0 / 16 + kt) * 16 + fr;
            const bf16x8 kb0 = *(const bf16x8*)(KS + key * KST + fq * 8), kb1 = *(const bf16x8*)(KS + key * KST + 32 + fq * 8);
            f32x4 a = (f32x4){0.f, 0.f, 0.f, 0.f};
            a = __builtin_amdgcn_mfma_f32_16x16x32_bf16(qa0, kb0, a, 0, 0, 0); a = __builtin_amdgcn_mfma_f32_16x16x32_bf16(qa1, kb1, a, 0, 0, 0);
#pragma unroll
            for (int r = 0; r < 4; ++r) {
                const int qi = q0 + fq * 4 + r;
                const bool ok = (key > qi) && (key <= qi + 128) && (nb > 0 || key >= 128);
                a[r] = ok ? a[r] : -1e30f;
            }
            sc[kt] = a;
        }
        float m4[4], s4[4];
#pragma unroll
        for (int r = 0; r < 4; ++r) {
            float m = sc[0][r];
#pragma unroll
            for (int kt = 1; kt < 9; ++kt) m = fmaxf(m, sc[kt][r]);
            m = row16_max(m);
            m4[r] = fmaxf(m, sink);
            float s = 0.f;
#pragma unroll
            for (int kt = 0; kt < 9; ++kt) { const float e = __expf(sc[kt][r] - m4[r]); sc[kt][r] = e; s += e; }
            s = row16_sum(s);
            s4[r] = __builtin_amdgcn_rcpf(s + __expf(sink - m4[r]));
        }
#pragma unroll
        for (int kt = 0; kt < 9; ++kt)
#pragma unroll
            for (int r = 0; r < 4; ++r) PS[(fq * 4 + r) * PST + kt * 16 + fr] = (bf16)f2bf(sc[kt][r] * s4[r]);
#pragma unroll
        for (int r = 0; r < 4; ++r) PS[(fq * 4 + r) * PST + 144 + fr] = 0;
        LDS_WAIT();
        f32x4 o[4];
#pragma unroll
        for (int dt = 0; dt < 4; ++dt) o[dt] = (f32x4){0.f, 0.f, 0.f, 0.f};
#pragma unroll
        for (int ks = 0; ks < 5; ++ks) {
            const bf16x8 pa = *(const bf16x8*)(PS + fr * PST + ks * 32 + fq * 8);
#pragma unroll
            for (int dt = 0; dt < 4; ++dt) {
                const bf16x8 vb = *(const bf16x8*)(VT + (dt * 16 + fr) * VST + q0 + ks * 32 + fq * 8);
                o[dt] = __builtin_amdgcn_mfma_f32_16x16x32_bf16(pa, vb, o[dt], 0, 0, 0);
            }
        }
        LDS_WAIT();
#pragma unroll
        for (int r = 0; r < 4; ++r)
#pragma unroll
            for (int dt = 0; dt < 4; ++dt) PS[(fq * 4 + r) * PST + dt * 16 + fr] = (bf16)f2bf(o[dt][r]);
        LDS_WAIT();
#pragma unroll
        for (int j = 0; j < 2; ++j) {
            const int tk = (lane >> 3) + 8 * j, c16 = lane & 7;
            const size_t t = (size_t)b * SEQ + nb * 128 + q0 + tk;
            *(u32x4*)(YB + t * 512 + hq * 64 + c16 * 8) = *(const u32x4*)(PS + tk * PST + c16 * 8);
        }
        LDS_WAIT();
    }
}

#define XB_TMO      128
#define XB_XCNT(j)  (256  + 64 * (j))
#define XB_XSUB(j)  (1280 + 64 * (j))
#define XB_XGEN(j)  (2304 + 64 * (j))
#define XB_TOP      3328
#define XB_TOPGEN   3392
#define XCD_BAR_WORDS 3456
#define XB_SPIN_CAP (1u << 18)

__device__ __forceinline__ unsigned xb_ld(unsigned* p)              { return __hip_atomic_load(p, __ATOMIC_RELAXED, __HIP_MEMORY_SCOPE_AGENT); }
__device__ __forceinline__ unsigned xb_add(unsigned* p, unsigned v) { return __hip_atomic_fetch_add(p, v, __ATOMIC_RELAXED, __HIP_MEMORY_SCOPE_AGENT); }
__device__ __forceinline__ unsigned xb_xcc_id() { return (unsigned)__builtin_amdgcn_s_getreg((3 << 11) | 20) & 0xFu; }
#define XB_SPIN(cond, bar) do { unsigned _sp = 0; while (cond) { __builtin_amdgcn_s_sleep(1); \
    if ((++_sp & 255u) == 0u) { if (xb_ld(&(bar)[XB_TMO])) break; if (_sp > XB_SPIN_CAP) { atomicAdd(&(bar)[XB_TMO], 1u); break; } } } } while (0)

struct XcdBarrier {
    unsigned* bar; unsigned x;
    volatile LAS unsigned* st;
};

__device__ __forceinline__ XcdBarrier xcd_barrier_post(unsigned* bar, volatile LAS unsigned* st) {
    XcdBarrier b; b.bar = bar; b.x = xb_xcc_id(); b.st = st;
    if (threadIdx.x == 0) (void)xb_add(&bar[XB_XCNT(b.x)], 1u);
    return b;
}
__device__ __forceinline__ void xcd_barrier_complete(unsigned* bar, unsigned x, unsigned& nloc, unsigned& nx) {
    const unsigned G = gridDim.x * gridDim.y * gridDim.z;
    unsigned sum, cnt, mine, sp = 0u;
    for (;;) {
        sum = 0u; cnt = 0u; mine = 0u;
#pragma unroll
        for (unsigned j = 0; j < 16; ++j) { const unsigned c = xb_ld(&bar[XB_XCNT(j)]); sum += c; cnt += (c > 0u) ? 1u : 0u; mine = (j == x) ? c : mine; }
        if (sum == G) break;
        __builtin_amdgcn_s_sleep(1);
        if ((++sp & 255u) == 0u) { if (xb_ld(&bar[XB_TMO])) break; if (sp > XB_SPIN_CAP) { atomicAdd(&bar[XB_TMO], 1u); break; } }
    }
    nloc = mine > 0u ? mine : 1u; nx = cnt > 0u ? cnt : 1u;
}

__device__ __forceinline__ void xcd_barrier(const XcdBarrier& b) {
    asm volatile("s_waitcnt vmcnt(0)" ::: "memory");
    __syncthreads();
    if (threadIdx.x == 0) {
        unsigned* bar = b.bar;
        __builtin_amdgcn_s_waitcnt(0);
        unsigned nloc = b.st[0], nx = b.st[1];
        if (nloc == 0u) { xcd_barrier_complete(bar, b.x, nloc, nx); b.st[0] = nloc; b.st[1] = nx; }
        const unsigned old = xb_add(&bar[XB_XSUB(b.x)], 1u);
        const unsigned gen = old / nloc;
        if (old + 1u == (gen + 1u) * nloc) {
            __builtin_amdgcn_fence(__ATOMIC_RELEASE, "agent");
            asm volatile("s_waitcnt vmcnt(0)" ::: "memory");
            const unsigned og = xb_add(&bar[XB_TOP], 1u);
            const unsigned tg = og / nx;
            if (og + 1u == (tg + 1u) * nx) xb_add(&bar[XB_TOPGEN], 1u);
            else XB_SPIN(xb_ld(&bar[XB_TOPGEN]) == tg, bar);
            __builtin_amdgcn_fence(__ATOMIC_ACQUIRE, "agent");
            xb_add(&bar[XB_XGEN(b.x)], 1u);
            asm volatile("s_waitcnt vmcnt(0)" ::: "memory");
        } else {
            XB_SPIN(xb_ld(&bar[XB_XGEN(b.x)]) == gen, bar);
            __builtin_amdgcn_fence(__ATOMIC_ACQUIRE, "agent");
            asm volatile("s_waitcnt vmcnt(0)" ::: "memory");
        }
    }
    __syncthreads();
}

struct Args { const void* in[29]; float* out; unsigned char* ws; };

__global__ void __launch_bounds__(512, 2) mega_fwd(Args a) {
    extern __shared__ __attribute__((aligned(16))) unsigned char lds[];
    cg::grid_group grid = cg::this_grid();
    const int wave = __builtin_amdgcn_readfirstlane(threadIdx.x >> 6);
    const int G = gridDim.x, NGW = G * 8, NGT = G * 512;
#define THREAD_IDS() const int lane = pg8::lane_id_fresh(); const int tid = wave * 64 + lane; const int gw = blockIdx.x * 8 + wave; const int gt = blockIdx.x * 512 + tid; (void)gw; (void)gt; (void)tid; (void)lane
    unsigned char* ws = a.ws;
    const float* x = (const float*)a.in[0];
    LAS unsigned char* ldsl = (LAS unsigned char*)lds;
    volatile LAS unsigned* bst = (volatile LAS unsigned*)(ldsl + LDS_BYTES - 16);
    unsigned* barw = (unsigned*)(ws + 0);
    if (threadIdx.x < 2) bst[threadIdx.x] = 0u;
    __syncthreads();
    if (a.ws == nullptr) grid.sync();
    XcdBarrier xbar = xcd_barrier_post(barw, bst);
#define GSYNC() xcd_barrier(xbar)

#ifndef REP_P0
#define REP_P0 1
#endif
#ifndef REP_P1
#define REP_P1 1
#endif
#ifndef REP_P2
#define REP_P2 1
#endif
#ifndef REP_P3
#define REP_P3 1
#endif
#ifndef REP_P4A
#define REP_P4A 1
#endif
#ifndef REP_P4B
#define REP_P4B 1
#endif
#ifndef REP_SCAN
#define REP_SCAN 1
#endif
#ifndef REP_ATT
#define REP_ATT 1
#endif
#ifndef REP_P6
#define REP_P6 1
#endif
#ifndef REP_P7
#define REP_P7 1
#endif
#ifndef REP_P8
#define REP_P8 1
#endif
#ifndef REP_P9
#define REP_P9 1
#endif
    for (int rep = 0; rep < REP_P0; ++rep) {
        THREAD_IDS();
        P0Args p{(const float*)a.in[7], (const float*)a.in[23], (const float*)a.in[24], (const float*)a.in[25], (const float*)a.in[26], (const float*)a.in[27], (const float*)a.in[28],
                 (const float*)a.in[3], (const float*)a.in[1], (const float*)a.in[10], (const float*)a.in[12], (const float*)a.in[13], ws};
        phase0(p, ldsl, gw, NGW, wave, lane, gt, NGT);
        GSYNC();
    }
#ifndef REP_SYNC
#define REP_SYNC 0
#endif
    for (int rs = 0; rs < REP_SYNC; ++rs) GSYNC();
    for (int rep = 0; rep < REP_P1; ++rep) {
        THREAD_IDS();
        const float* ada_b = (const float*)a.in[4];
        norm_mod_phase<true>(x, (const float*)a.in[5], ada_b, ws, 0, 1024, (bf16*)(ws + WS_HBUF), gw, NGW, lane);
        { const int* pos = (const int*)a.in[2]; float* rope = (float*)(ws + WS_ROPE);
          for (int i = gt; i < T * 8; i += NGT) { float cs, sn; rope_entry(pos[i >> 3], i & 7, cs, sn); rope[(size_t)(i >> 3) * 16 + (i & 7)] = cs; rope[(size_t)(i >> 3) * 16 + 8 + (i & 7)] = sn; } }
        const float* adap = (const float*)(ws + WS_ADAP); float* ada = (float*)(ws + WS_ADA);
        for (int i = gt; i < 8 * ADAW; i += NGT) { const int b = i / ADAW, j = i % ADAW; float s = ada_b[j]; for (int ks = 0; ks < KSPLIT; ++ks) s += adap[(size_t)(ks * 8 + b) * ADAW + j]; ada[i] = s; }
        GSYNC();
    }
    for (int rep = 0; rep < REP_P2; ++rep) {
        pg8::Gemm g{(const bf16*)(ws + WS_HBUF), (const bf16*)(ws + WS_WIN), T, INW, D, D}; pg8::StaticOrder S; S.init(T, INW, G, (int)blockIdx.x);
        EpiProj E{(bf16*)a.out, (bf16*)(ws + WS_QKVG), (const float*)a.in[22]};
        pg8::gemm_phase<EpiProj, pg8::StaticOrder, true, true>(ldsl, g, S, E, wave);
        GSYNC();
    }
    for (int rep = 0; rep < REP_P3; ++rep) {
        THREAD_IDS();
        P3Args p{(const bf16*)a.out, (const float*)a.in[8], (const float*)a.in[9], (const float*)a.in[11], (const float*)a.in[15], (const float*)a.in[16], ws};
        phase3(p, lds, tid, wave, lane);
        GSYNC();
    }
    for (int rep = 0; rep < REP_P4A; ++rep) {
        THREAD_IDS();
        PAArgs p{(const float*)a.in[14], (const float*)a.in[15], ws, (unsigned char*)a.out};
        ChunkRaw raw; chunk_load(p, blockIdx.x, wave, lane, raw);
        for (int it = blockIdx.x; it < 4096; it += G) {
            const ChunkRaw cur = raw;
            { const int nx = (it + G < 4096) ? it + G : it; chunk_load(p, nx, wave, lane, raw); }
            chunk_item(p, lds, it, tid, wave, lane, cur);
        }
        GSYNC();
    }
    for (int rep = 0; rep < REP_P4B; ++rep) {
        THREAD_IDS();
        if (blockIdx.x < 64) {
            PBArgs p{(const float*)a.in[17], (const float*)a.in[18], ws, (unsigned char*)a.out};
            for (int r2 = 0; r2 < REP_SCAN; ++r2) chunk_scan_m(p, lds, blockIdx.x, tid, wave, lane);
        } else {
            AtArgs p{(const float*)a.in[19], (const float*)a.in[20], (const float*)a.in[21], (const int*)a.in[2], ws};
            for (int r2 = 0; r2 < REP_ATT; ++r2) for (int u = blockIdx.x - 64; u < 512; u += G - 64) attn_unit(p, lds, u, tid, wave, lane);
        }
        GSYNC();
    }
    {
        THREAD_IDS();
        PBArgs p{(const float*)a.in[17], (const float*)a.in[18], ws, (unsigned char*)a.out};
        chunk_out(p, lds, G, wave, lane);
        GSYNC();
    }
    for (int rep = 0; rep < REP_P6; ++rep) {
        pg8::StaticOrder S; S.init(T, D, G, (int)blockIdx.x);
        { pg8::Gemm g{(const bf16*)(ws + WS_YA), (const bf16*)(ws + WS_WA), T, D, 512, 512}; EpiBranch<0> E{(const bf16*)(ws + WS_QKVG), a.out, (bf16*)(ws + WS_HBUF)};
          pg8::gemm_phase<EpiBranch<0>, pg8::StaticOrder, true, true>(ldsl, g, S, E, wave); }
        { pg8::Gemm g{(const bf16*)(ws + WS_YB), (const bf16*)(ws + WS_WB), T, D, 512, 512}; EpiBranch<1> E{(const bf16*)(ws + WS_QKVG), a.out, (bf16*)(ws + WS_HBUF)};
          pg8::gemm_phase<EpiBranch<1>, pg8::StaticOrder, true, true>(ldsl, g, S, E, wave); }
        GSYNC();
    }
    for (int rep = 0; rep < REP_P7; ++rep) {
        pg8::Gemm g{(const bf16*)(ws + WS_HBUF), (const bf16*)(ws + WS_WOUT), T, D, D, D}; pg8::StaticOrder S; S.init(T, D, G, (int)blockIdx.x);
        EpiResNorm E{x, a.out, (const float*)(ws + WS_ADA) + 2048, (const float*)(ws + WS_ADA), (const float*)a.in[6], (float*)(ws + WS_SLOT), (unsigned*)(ws + 16384), (bf16*)(ws + WS_HBUF)};
        pg8::gemm_phase<EpiResNorm, pg8::StaticOrder, true, true>(ldsl, g, S, E, wave);
        GSYNC();
    }
    for (int rep = 0; rep < REP_P8 - 1; ++rep) {
        THREAD_IDS();
        norm_mod_phase<false>(a.out, (const float*)a.in[6], (const float*)a.in[4], ws, 3072, 4096, (bf16*)(ws + WS_HBUF), gw, NGW, lane);
        GSYNC();
    }
    for (int rep = 0; rep < REP_P9; ++rep) {
        pg8::Gemm g{(const bf16*)(ws + WS_HBUF), (const bf16*)(ws + WS_W13), T, 2 * FF, D, D}; pg8::StaticOrder S; S.init(T, 2 * FF, G, (int)blockIdx.x);
        EpiSwiglu E{(bf16*)(ws + WS_QKVG)};
        pg8::gemm_phase<EpiSwiglu, pg8::StaticOrder, true, true>(ldsl, g, S, E, wave);
        GSYNC();
    }
    {
        pg8::Gemm g{(const bf16*)(ws + WS_QKVG), (const bf16*)(ws + WS_W2), T, D, FF, FF}; pg8::StaticOrder S; S.init(T, D, G, (int)blockIdx.x);
        EpiRes E{a.out, a.out, (const float*)(ws + WS_ADA) + 5120};
        pg8::gemm_phase<EpiRes, pg8::StaticOrder, true, true>(ldsl, g, S, E, wave);
    }
}

extern "C" void kernel_launch(void* const* d_in, const int* in_sizes, int n_in, void* d_out, int out_size, void* d_ws, size_t ws_size, hipStream_t stream) {
    static int grid_blocks = 0;
    if (grid_blocks == 0) {
        if (n_in != 29 || out_size != T * D || ws_size < WS_END) { fprintf(stderr, "kernel_launch: unexpected shapes (n_in %d out %d ws %zu)\n", n_in, out_size, ws_size); grid_blocks = -1; return; }
        int dev = 0, cus = 0, per_cu = 0;
        hipGetDevice(&dev);
        hipDeviceGetAttribute(&cus, hipDeviceAttributeMultiprocessorCount, dev);
        hipFuncSetAttribute((const void*)mega_fwd, hipFuncAttributeMaxDynamicSharedMemorySize, LDS_BYTES);
        hipOccupancyMaxActiveBlocksPerMultiprocessor(&per_cu, (const void*)mega_fwd, 512, LDS_BYTES);
        if (per_cu < 1) { fprintf(stderr, "kernel_launch: occupancy query gives %d\n", per_cu); per_cu = 1; }
        (void)hipGetLastError();
        grid_blocks = cus * per_cu;
    }
    if (grid_blocks < 0) return;
    if (hipMemsetAsync(d_ws, 0, 32768, stream) != hipSuccess) { fprintf(stderr, "kernel_launch: memset of the barrier words failed\n"); return; }
    Args a{};
    for (int i = 0; i < 29; ++i) a.in[i] = d_in[i];
    a.out = (float*)d_out; a.ws = (unsigned char*)d_ws;
    void* args[] = {&a};
    hipError_t e = hipLaunchCooperativeKernel((const void*)mega_fwd, dim3(grid_blocks), dim3(512), args, LDS_BYTES, stream);
    if (e != hipSuccess) fprintf(stderr, "cooperative launch failed: %s (grid %d)\n", hipGetErrorString(e), grid_blocks);
}
```

```cpp
#include <hip/hip_runtime.h>
#include <hip/hip_cooperative_groups.h>
#include <cstdio>
#include <cstdint>
namespace cg = cooperative_groups;

namespace pg8 {
#define PG8_LAS __attribute__((address_space(3)))
typedef unsigned short bf16_t;
typedef short bf16x8 __attribute__((ext_vector_type(8)));
typedef float f32x4 __attribute__((ext_vector_type(4)));
typedef unsigned u32x4 __attribute__((ext_vector_type(4)));
constexpr int BM = 256, BK = 64, HALF = 128, HTB = HALF * BK * 2  , STAGE_BYTES = 8 * HTB, NXCD = 8, WGM = 8;

__host__ __device__ __forceinline__ int lds_byte(int r, int c) { const int st = (r >> 4) * 2 + (c >> 5), rr = r & 15, cc = c & 31, ob = rr * 64 + cc * 2; return st * 1024 + (ob ^ (((ob >> 9) & 1) << 5)); }
__host__ __device__ __forceinline__ void stage_rc(int b, int& R, int& C) { const int st = b / 1024, sb = b % 1024, swz = sb ^ (((sb >> 9) & 1) << 5); R = (st >> 1) * 16 + swz / 64; C = (st & 1) * 32 + (swz % 64) / 2; }
__host__ __device__ __forceinline__ int perm32(int rho) { const int n = rho >> 4, i = rho & 15; return 8 * (i >> 2) + 4 * n + (i & 3); }

__device__ __forceinline__ int lane_id_fresh() { int l; asm volatile("v_mbcnt_lo_u32_b32 %0, -1, 0\n\tv_mbcnt_hi_u32_b32 %0, -1, %0" : "=v"(l)); return l; }
struct Unit { int pm, pn; };
struct Gemm { const bf16_t* A; const bf16_t* Bt; int M, N, K, lda; };

struct StaticOrder {
    int nM, nN, nwg, G, c;
    __host__ __device__ void init(int M, int N, int G_, int c_) { nM = M / BM; nN = N / BM; nwg = nM * nN; G = G_; c = c_; }
    __host__ __device__ bool next(int i, Unit& u) const {
        const long L = (long)i * G + c; if (L >= nwg) return false;
        int wgid = (int)L; { const int q = nwg / NXCD, r = nwg % NXCD, xcd = wgid % NXCD, off = wgid / NXCD; wgid = (xcd < r ? xcd * (q + 1) : r * (q + 1) + (xcd - r) * q) + off; }
        const int nig = WGM * nN, gid = wgid / nig, fm = gid * WGM, gsz = (nM - fm) < WGM ? (nM - fm) : WGM;
        u.pm = fm + ((wgid % nig) % gsz); u.pn = (wgid % nig) / gsz; return true;
    }
    __device__ __forceinline__ void a_ready(const Unit&) const {}
    __device__ __forceinline__ void done(const Unit&) const {}
};

__device__ __forceinline__ unsigned cvt_pk_bf16(float lo, float hi) { unsigned r; asm volatile("v_cvt_pk_bf16_f32 %0, %1, %2" : "=v"(r) : "v"(lo), "v"(hi)); return r; }
template <class Epi, class Sched, bool ALIGN_EPI = false, bool SP2 = false>
__device__ __forceinline__ void gemm_phase(PG8_LAS unsigned char* lds, const Gemm g, const Sched& S, const Epi& E, int wave_in) {
    const int wid = wave_in, lane = lane_id_fresh(), tid = wid * 64 + lane, wr = wid >> 2, wc = wid & 3, fr = lane & 15, fq = lane >> 4;
    const int K = g.K, nt = K / BK;
    unsigned voffA[2], voffB[2];
#pragma unroll
    for (int i = 0; i < 2; ++i) { int R, C; stage_rc(tid * 16 + i * 8192, R, C); const int Rb = Epi::PERM ? ((R & ~31) + perm32(R & 31)) : R;
        voffA[i] = (unsigned)(R * g.lda + C) * 2u; voffB[i] = (unsigned)(Rb * K + C) * 2u; }
    const size_t kstep = (size_t)(BK * 2);
    const size_t hstepA = (size_t)HALF * g.lda * 2, hstepB = (size_t)HALF * K * 2;
    const size_t tstepA = 2 * hstepA, tstepB = 2 * hstepB;
    const unsigned ldsw = (unsigned)wid * 1024u;
    const int aoff = lds_byte(wr * 64 + fr, fq * 8), boff = lds_byte(wc * 32 + fr, fq * 8);
#define PG8_SA(b, h) (((b) * 2 + (h)) * HTB)
#define PG8_SB(b, h) ((4 + (b) * 2 + (h)) * HTB)
#define PG8_STAGE(bufoff, gbase, voff) do { _Pragma("unroll") for (int _i = 0; _i < 2; ++_i) \
        __builtin_amdgcn_global_load_lds((const unsigned*)((const char*)(gbase) + (voff)[_i]), (PG8_LAS unsigned*)(lds + (bufoff) + ldsw + _i * 8192), 16, 0, 0); } while (0)
#define PG8_LDA(dst, b, h) do { _Pragma("unroll") for (int m = 0; m < 4; ++m) _Pragma("unroll") for (int k = 0; k < 2; ++k) dst[m][k] = *(const PG8_LAS bf16x8*)(lds + PG8_SA(b, h) + aoff + m * 2048 + k * 1024); } while (0)
#define PG8_LDB(dst, b, h) do { _Pragma("unroll") for (int n = 0; n < 2; ++n) _Pragma("unroll") for (int k = 0; k < 2; ++k) dst[n][k] = *(const PG8_LAS bf16x8*)(lds + PG8_SB(b, h) + boff + n * 2048 + k * 1024); } while (0)
#define PG8_MMA(ai, bj, At, Bt) do { __builtin_amdgcn_s_setprio(1); _Pragma("unroll") for (int m = 0; m < 4; ++m) _Pragma("unroll") for (int n = 0; n < 2; ++n) _Pragma("unroll") for (int k = 0; k < 2; ++k) \
        acc[ai][bj][m][n] = __builtin_amdgcn_mfma_f32_16x16x32_bf16(Bt[n][k], At[m][k], acc[ai][bj][m][n], 0, 0, 0); __builtin_amdgcn_s_setprio(0); } while (0)
#define PG8_WAIT_V(n) asm volatile("s_waitcnt vmcnt(" #n ")" ::: "memory")
#define PG8_WAIT_L(n) asm volatile("s_waitcnt lgkmcnt(" #n ")" ::: "memory")
#define PG8_BAR __builtin_amdgcn_s_barrier()
#define PG8_SCHED __builtin_amdgcn_sched_barrier(0)
    Unit cur, nxt; int ui = 0;
    if (!S.next(0, cur)) return;
    f32x4 acc[2][2][4][2];
#pragma unroll
    for (int a = 0; a < 2; ++a)
#pragma unroll
        for (int b = 0; b < 2; ++b)
#pragma unroll
            for (int m = 0; m < 4; ++m)
#pragma unroll
                for (int n = 0; n < 2; ++n) acc[a][b][m][n] = (f32x4){0.f, 0.f, 0.f, 0.f};
    bf16x8 At[4][2], B0[2][2], B1[2][2];
    const char* cA = (const char*)g.A + (size_t)cur.pm * tstepA; const char* cB = (const char*)g.Bt + (size_t)cur.pn * tstepB;
    S.a_ready(cur);
    if constexpr (SP2) {
        PG8_STAGE(PG8_SB(0, 0), cB, voffB); PG8_STAGE(PG8_SB(0, 1), cB + hstepB, voffB); PG8_STAGE(PG8_SA(0, 0), cA, voffA); PG8_STAGE(PG8_SA(0, 1), cA + hstepA, voffA);
        if (wr == 1) PG8_BAR;
        PG8_WAIT_V(2); PG8_BAR;
        PG8_STAGE(PG8_SB(1, 0), cB + kstep, voffB); PG8_STAGE(PG8_SA(1, 0), cA + kstep, voffA); PG8_STAGE(PG8_SB(1, 1), cB + hstepB + kstep, voffB);
        PG8_WAIT_V(6); PG8_BAR;
    } else {
        PG8_STAGE(PG8_SB(0, 0), cB, voffB); PG8_STAGE(PG8_SA(0, 0), cA, voffA); PG8_STAGE(PG8_SB(0, 1), cB + hstepB, voffB); PG8_STAGE(PG8_SA(0, 1), cA + hstepA, voffA);
        if (wr == 1) PG8_BAR;
        PG8_WAIT_V(4); PG8_BAR;
        PG8_STAGE(PG8_SB(1, 0), cB + kstep, voffB); PG8_STAGE(PG8_SA(1, 0), cA + kstep, voffA); PG8_STAGE(PG8_SB(1, 1), cB + hstepB + kstep, voffB);
        PG8_WAIT_V(6); PG8_BAR;
    }
    for (;;) {
        const bool has_next = S.next(ui + 1, nxt);
        const char* nA = has_next ? (const char*)g.A + (size_t)nxt.pm * tstepA : cA; const char* nB = has_next ? (const char*)g.Bt + (size_t)nxt.pn * tstepB : cB;
        for (int t = 0; t < nt; t += 2) {
            const bool last = (t == nt - 2);
            const char* a1 = cA + (size_t)(t + 1) * kstep;
            const char* a2 = last ? nA : cA + (size_t)(t + 2) * kstep; const char* b2 = last ? nB : cB + (size_t)(t + 2) * kstep;
            const char* a3 = a2 + kstep; const char* b3 = b2 + kstep;
            if (last && has_next) S.a_ready(nxt);
            if constexpr (SP2) {
            PG8_LDB(B0, 0, 0); PG8_LDB(B1, 0, 1); PG8_SCHED; PG8_LDA(At, 0, 0); PG8_STAGE(PG8_SA(1, 1), a1 + hstepA, voffA);
            PG8_WAIT_V(8); PG8_WAIT_L(0); PG8_BAR; PG8_MMA(0, 0, At, B0); PG8_MMA(0, 1, At, B1); PG8_BAR; PG8_SCHED;
            PG8_LDA(At, 0, 1); PG8_STAGE(PG8_SB(0, 0), b2, voffB); PG8_STAGE(PG8_SB(0, 1), b2 + hstepB, voffB); PG8_STAGE(PG8_SA(0, 0), a2, voffA);
            PG8_WAIT_V(8); PG8_WAIT_L(0); PG8_BAR; PG8_MMA(1, 0, At, B0); PG8_MMA(1, 1, At, B1); PG8_BAR; PG8_SCHED;
            PG8_LDB(B0, 1, 0); PG8_LDB(B1, 1, 1); PG8_SCHED; PG8_LDA(At, 1, 0); PG8_STAGE(PG8_SA(0, 1), a2 + hstepA, voffA);
            PG8_WAIT_V(8); PG8_WAIT_L(0); PG8_BAR; PG8_MMA(0, 0, At, B0); PG8_MMA(0, 1, At, B1); PG8_BAR; PG8_SCHED;
            PG8_LDA(At, 1, 1); PG8_STAGE(PG8_SB(1, 0), b3, voffB); PG8_STAGE(PG8_SB(1, 1), b3 + hstepB, voffB); PG8_STAGE(PG8_SA(1, 0), a3, voffA);
            PG8_WAIT_V(8); PG8_WAIT_L(0); PG8_BAR; PG8_MMA(1, 0, At, B0); PG8_MMA(1, 1, At, B1); PG8_BAR; PG8_SCHED;
            } else {
            PG8_LDB(B0, 0, 0); PG8_SCHED; PG8_LDA(At, 0, 0); PG8_STAGE(PG8_SA(1, 1), a1 + hstepA, voffA);
            PG8_WAIT_L(8); PG8_BAR; PG8_WAIT_L(0); PG8_MMA(0, 0, At, B0); PG8_BAR; PG8_SCHED;
            PG8_LDB(B1, 0, 1); PG8_STAGE(PG8_SB(0, 0), b2, voffB);
            PG8_BAR; PG8_WAIT_L(0); PG8_MMA(0, 1, At, B1); PG8_BAR;
            PG8_LDA(At, 0, 1); PG8_STAGE(PG8_SA(0, 0), a2, voffA);
            PG8_BAR; PG8_WAIT_L(0); PG8_MMA(1, 0, At, B0); PG8_BAR; PG8_SCHED;
            PG8_STAGE(PG8_SB(0, 1), b2 + hstepB, voffB);
            PG8_WAIT_V(6); PG8_BAR; PG8_MMA(1, 1, At, B1); PG8_BAR;
            PG8_LDB(B0, 1, 0); PG8_SCHED; PG8_LDA(At, 1, 0); PG8_STAGE(PG8_SA(0, 1), a2 + hstepA, voffA);
            PG8_WAIT_L(8); PG8_BAR; PG8_WAIT_L(0); PG8_MMA(0, 0, At, B0); PG8_BAR; PG8_SCHED;
            PG8_LDB(B1, 1, 1); PG8_STAGE(PG8_SB(1, 0), b3, voffB);
            PG8_BAR; PG8_WAIT_L(0); PG8_MMA(0, 1, At, B1); PG8_BAR;
            PG8_LDA(At, 1, 1); PG8_STAGE(PG8_SA(1, 0), a3, voffA);
            PG8_BAR; PG8_WAIT_L(0); PG8_MMA(1, 0, At, B0); PG8_BAR; PG8_SCHED;
            PG8_STAGE(PG8_SB(1, 1), b3 + hstepB, voffB);
            PG8_WAIT_V(6); PG8_BAR; PG8_MMA(1, 1, At, B1); PG8_BAR;
            }
        }
        if constexpr (ALIGN_EPI) { if (wr == 0) PG8_BAR; }
        if constexpr (!Epi::AFTER_DRAIN) { E(acc, cur, wr, wc, fr, fq); S.done(cur); }
        if (!has_next) break;
#pragma unroll
        for (int a = 0; a < 2; ++a)
#pragma unroll
            for (int b = 0; b < 2; ++b)
#pragma unroll
                for (int m = 0; m < 4; ++m)
#pragma unroll
                    for (int n = 0; n < 2; ++n) acc[a][b][m][n] = (f32x4){0.f, 0.f, 0.f, 0.f};
        cur = nxt; cA = nA; cB = nB; ++ui;
        if constexpr (ALIGN_EPI) { if (wr == 1) PG8_BAR; }
    }
    PG8_WAIT_V(0);
    if constexpr (!ALIGN_EPI) { if (wr == 0) PG8_BAR; }
    PG8_BAR;
    if constexpr (Epi::AFTER_DRAIN) { E.fused(acc, cur, wr, wc, fr, fq, lds, wid, lane); S.done(cur); }
#undef PG8_SA
#undef PG8_SB
#undef PG8_STAGE
#undef PG8_LDA
#undef PG8_LDB
#undef PG8_MMA
#undef PG8_WAIT_V
#undef PG8_WAIT_L
#undef PG8_BAR
#undef PG8_SCHED
}
}

#define LAS __attribute__((address_space(3)))
typedef unsigned short bf16;
typedef short bf16x8 __attribute__((ext_vector_type(8)));
typedef float f32x4 __attribute__((ext_vector_type(4)));
typedef unsigned u32x4 __attribute__((ext_vector_type(4)));
typedef unsigned u32x2 __attribute__((ext_vector_type(2)));

constexpr int BATCH = 8, SEQ = 4096, T = BATCH * SEQ, D = 1024, INW = 4608, RW = 1792, QW = 2816, FF = 2816, ADAW = 6144;
constexpr int QC_Q = 0, QC_K = 512, QC_V = 640, QC_GA = 768, QC_GB = 1792;
constexpr size_t MiB = 1u << 20;
constexpr size_t WS_WIN = 1 * MiB, WS_WA = 10 * MiB, WS_WB = 11 * MiB, WS_WOUT = 12 * MiB, WS_W13 = 14 * MiB, WS_W2 = 25 * MiB;
constexpr size_t WS_DUT = 31 * MiB, WS_IUT = WS_DUT + 65536, WS_GUT = WS_IUT + 65536;
constexpr size_t WS_ADAP = 32 * MiB, WS_ADA = 35 * MiB, WS_RK = 36 * MiB;
constexpr size_t WS_HBUF = 40 * MiB, WS_QKVG = 104 * MiB, WS_R = 280 * MiB, WS_K = 312 * MiB, WS_V = 344 * MiB, WS_LW = 376 * MiB, WS_YA = 376 * MiB  , WS_MC = 408 * MiB  , WS_PG = 440 * MiB, WS_YB = 472 * MiB, WS_ROPE = 504 * MiB  , WS_SLOT = 506 * MiB  , WS_END = 508 * MiB;
constexpr size_t DO_QG = 0, DO_Y0 = 64 * MiB, DO_RP = 96 * MiB;
constexpr int LDS_BYTES = 147456;
constexpr int KSPLIT = 16;

__device__ __forceinline__ float bf2f(bf16 v) { return __uint_as_float((unsigned)v << 16); }
typedef float f32x2_t __attribute__((ext_vector_type(2))); typedef __bf16 bf16x2_t __attribute__((ext_vector_type(2)));
__device__ __forceinline__ unsigned pk2(float lo, float hi) { f32x2_t v = {lo, hi}; bf16x2_t b = __builtin_convertvector(v, bf16x2_t); return __builtin_bit_cast(unsigned, b); }
__device__ __forceinline__ unsigned f2bf(float f) { return pk2(f, f) & 0xffffu; }
__device__ __forceinline__ float sigmoidf_(float x) { return __builtin_amdgcn_rcpf(1.0f + __expf(-x)); }
template <int CTRL, int ROWMASK> __device__ __forceinline__ float dpp_perm(float v) {
    return __int_as_float(__builtin_amdgcn_update_dpp(0, __float_as_int(v), CTRL, ROWMASK, 0xF, false));
}
__device__ __forceinline__ float wave_sum(float v) {
    v += dpp_perm<0xB1, 0xF>(v);
    v += dpp_perm<0x4E, 0xF>(v);
    v += dpp_perm<0x141, 0xF>(v);
    v += dpp_perm<0x140, 0xF>(v);
    v += dpp_perm<0x142, 0xA>(v);
    v += dpp_perm<0x143, 0xC>(v);
    return __int_as_float(__builtin_amdgcn_readlane(__float_as_int(v), 63));
}
__device__ __forceinline__ float row16_sum(float v) { v += dpp_perm<0xB1, 0xF>(v); v += dpp_perm<0x4E, 0xF>(v); v += dpp_perm<0x141, 0xF>(v); v += dpp_perm<0x140, 0xF>(v); return v; }
__device__ __forceinline__ float row16_max(float v) { v = fmaxf(v, dpp_perm<0xB1, 0xF>(v)); v = fmaxf(v, dpp_perm<0x4E, 0xF>(v)); v = fmaxf(v, dpp_perm<0x141, 0xF>(v)); v = fmaxf(v, dpp_perm<0x140, 0xF>(v)); return v; }
__device__ __forceinline__ float rows4_sum(float v) {
    { auto r = __builtin_amdgcn_permlane32_swap(__float_as_uint(v), __float_as_uint(v), false, false); v = __uint_as_float(r[0]) + __uint_as_float(r[1]); }
    { auto r = __builtin_amdgcn_permlane16_swap(__float_as_uint(v), __float_as_uint(v), false, false); v = __uint_as_float(r[0]) + __uint_as_float(r[1]); }
    return v;
}
#define LDS_WAIT() asm volatile("s_waitcnt lgkmcnt(0)" ::: "memory")
#define LBAR() do { asm volatile("s_waitcnt lgkmcnt(0)" ::: "memory"); __builtin_amdgcn_s_barrier(); asm volatile("" ::: "memory"); } while (0)
__device__ __forceinline__ f32x4 bf4(u32x2 w) { return (f32x4){__uint_as_float(w.x << 16), __uint_as_float(w.x & 0xffff0000u), __uint_as_float(w.y << 16), __uint_as_float(w.y & 0xffff0000u)}; }

using pg8::Unit;
using pg8::cvt_pk_bf16;
constexpr int HALF = 128;

struct EpiProj {
    static constexpr bool PERM = true, AFTER_DRAIN = false;
    bf16* Rb; bf16* Q; const float* gbias;
    __device__ __forceinline__ void operator()(const f32x4 (&acc)[2][2][4][2], const Unit& u, int wr, int wc, int fr, int fq) const {
        const int row0 = u.pm * 256 + wr * 64 + fr; const int colt = u.pn * 256;
        bf16* base; int ldc, c0;
        if (u.pn < 7) { base = Rb; ldc = RW; c0 = colt; } else { base = Q; ldc = QW; c0 = colt - RW; }
        const bool gate = u.pn >= 10;
        const int col0 = c0 + wc * 32 + 8 * fq;
#pragma unroll
        for (int bj = 0; bj < 2; ++bj) {
            f32x4 b0 = (f32x4){0.f, 0.f, 0.f, 0.f}, b1 = b0;
            if (gate) { const float* gp = gbias + (colt - 2560) + bj * HALF + wc * 32 + 8 * fq; b0 = *(const f32x4*)gp; b1 = *(const f32x4*)(gp + 4); }
#pragma unroll
            for (int ai = 0; ai < 2; ++ai)
#pragma unroll
                for (int m = 0; m < 4; ++m) {
                    f32x4 v0 = acc[ai][bj][m][0], v1 = acc[ai][bj][m][1];
                    if (gate) {
                        v0 += b0; v1 += b1;
#pragma unroll
                        for (int i = 0; i < 4; ++i) { v0[i] = sigmoidf_(v0[i]); v1[i] = sigmoidf_(v1[i]); }
                    }
                    u32x4 w; w.x = cvt_pk_bf16(v0[0], v0[1]); w.y = cvt_pk_bf16(v0[2], v0[3]); w.z = cvt_pk_bf16(v1[0], v1[1]); w.w = cvt_pk_bf16(v1[2], v1[3]);
                    *(u32x4*)(base + (size_t)(row0 + ai * HALF + m * 16) * ldc + col0 + bj * HALF) = w;
                }
        }
    }
};

__device__ __forceinline__ void bf8(u32x4 w, f32x4& lo, f32x4& hi) {
    lo = (f32x4){__uint_as_float(w.x << 16), __uint_as_float(w.x & 0xffff0000u), __uint_as_float(w.y << 16), __uint_as_float(w.y & 0xffff0000u)};
    hi = (f32x4){__uint_as_float(w.z << 16), __uint_as_float(w.z & 0xffff0000u), __uint_as_float(w.w << 16), __uint_as_float(w.w & 0xffff0000u)};
}
template <int MODE> struct EpiBranch {
    static constexpr bool PERM = true, AFTER_DRAIN = false;
    const bf16* Q; float* tmp; bf16* merged;
    __device__ __forceinline__ void operator()(const f32x4 (&acc)[2][2][4][2], const Unit& u, int wr, int wc, int fr, int fq) const {
        const int row0 = u.pm * 256 + wr * 64 + fr; const int col0 = u.pn * 256 + wc * 32 + 8 * fq;
#pragma unroll
        for (int ai = 0; ai < 2; ++ai)
#pragma unroll
            for (int m = 0; m < 4; ++m) {
                const size_t row = (size_t)(row0 + ai * HALF + m * 16);
#pragma unroll
                for (int bj = 0; bj < 2; ++bj) {
                    const int col = col0 + bj * HALF;
                    f32x4 g0, g1; bf8(*(const u32x4*)(Q + row * QW + (MODE == 0 ? QC_GA : QC_GB) + col), g0, g1);
                    f32x4 v0 = acc[ai][bj][m][0] * g0, v1 = acc[ai][bj][m][1] * g1;
                    if (MODE == 1) { f32x4 t0, t1; bf8(*(const u32x4*)(merged + row * D + col), t0, t1); v0 += t0; v1 += t1; }
                    u32x4 w; w.x = cvt_pk_bf16(v0[0], v0[1]); w.y = cvt_pk_bf16(v0[2], v0[3]); w.z = cvt_pk_bf16(v1[0], v1[1]); w.w = cvt_pk_bf16(v1[2], v1[3]);
                    *(u32x4*)(merged + row * D + col) = w;
                }
            }
    }
};

struct EpiRes {
    static constexpr bool PERM = false, AFTER_DRAIN = false;
    const float* base; float* out; const float* gate;
    __device__ __forceinline__ void operator()(const f32x4 (&acc)[2][2][4][2], const Unit& u, int wr, int wc, int fr, int fq) const {
        const int row0 = u.pm * 256 + wr * 64 + fr; const int col0 = u.pn * 256 + wc * 32 + 4 * fq;
        const float* gp = gate + (size_t)(u.pm / 16) * ADAW;
#pragma unroll
        for (int bj = 0; bj < 2; ++bj)
#pragma unroll
            for (int n = 0; n < 2; ++n) {
                const int col = col0 + bj * HALF + n * 16;
                const f32x4 g = *(const f32x4*)(gp + col);
#pragma unroll
                for (int ai = 0; ai < 2; ++ai)
#pragma unroll
                    for (int m = 0; m < 4; ++m) {
                        const size_t off = (size_t)(row0 + ai * HALF + m * 16) * D + col;
                        *(f32x4*)(out + off) = *(const f32x4*)(base + off) + g * acc[ai][bj][m][n];
                    }
            }
    }
};


struct EpiResNorm {
    static constexpr bool PERM = true, AFTER_DRAIN = false;
    const float* base; float* out; const float* gate; const float* ada; const float* g2; float* slots; unsigned* cnt; bf16* H2;
    __device__ __forceinline__ void operator()(f32x4 (&acc)[2][2][4][2], const Unit& u, int wr, int wc, int fr, int fq) const {
        const int row0 = u.pm * 256 + wr * 64 + fr; const int col0 = u.pn * 256 + wc * 32 + 8 * fq;
        const int b = u.pm / 16;
#pragma unroll
        for (int bj = 0; bj < 2; ++bj) {
            const int col = col0 + bj * HALF;
            const f32x4 g0 = *(const f32x4*)(gate + (size_t)b * ADAW + col), g1 = *(const f32x4*)(gate + (size_t)b * ADAW + col + 4);
#pragma unroll
            for (int ai = 0; ai < 2; ++ai)
#pragma unroll
                for (int m = 0; m < 4; ++m) {
                    const size_t off = (size_t)(row0 + ai * HALF + m * 16) * D + col;
                    const f32x4 x0 = *(const f32x4*)(base + off) + g0 * acc[ai][bj][m][0], x1 = *(const f32x4*)(base + off + 4) + g1 * acc[ai][bj][m][1];
                    *(f32x4*)(out + off) = x0; *(f32x4*)(out + off + 4) = x1;
                    acc[ai][bj][m][0] = x0; acc[ai][bj][m][1] = x1;
                }
        }
#pragma unroll
        for (int ai = 0; ai < 2; ++ai)
#pragma unroll
            for (int m = 0; m < 4; ++m) {
                float s = 0.f;
#pragma unroll
                for (int bj = 0; bj < 2; ++bj)
#pragma unroll
                    for (int n = 0; n < 2; ++n) { const f32x4 v = acc[ai][bj][m][n]; s += (v[0] * v[0] + v[1] * v[1]) + (v[2] * v[2] + v[3] * v[3]); }
                s = rows4_sum(s);
                if (fq == 0) __hip_atomic_store(slots + (size_t)(row0 + ai * HALF + m * 16) * 16 + u.pn * 4 + wc, s, __ATOMIC_RELAXED, __HIP_MEMORY_SCOPE_AGENT);
            }
        asm volatile("s_waitcnt vmcnt(0)" ::: "memory");
        unsigned* c = cnt + 16 * u.pm;
        if ((fr | fq) == 0) __hip_atomic_fetch_add(c, 1u, __ATOMIC_RELAXED, __HIP_MEMORY_SCOPE_AGENT);
        for (unsigned sp = 0; sp < (1u << 22); ++sp) {
            if ((unsigned)__builtin_amdgcn_readfirstlane((int)__hip_atomic_load(c, __ATOMIC_RELAXED, __HIP_MEMORY_SCOPE_AGENT)) >= 32u) break;
            __builtin_amdgcn_s_sleep(2);
        }
        __builtin_amdgcn_fence(__ATOMIC_ACQUIRE, "agent");
        f32x4 sc[2][2], sh[2][2];
#pragma unroll
        for (int bj = 0; bj < 2; ++bj)
#pragma unroll
            for (int n = 0; n < 2; ++n) {
                const int col = col0 + bj * HALF + n * 4;
                sc[bj][n] = *(const f32x4*)(g2 + col) * (*(const f32x4*)(ada + (size_t)b * ADAW + 4096 + col) + 1.0f);
                sh[bj][n] = *(const f32x4*)(ada + (size_t)b * ADAW + 3072 + col);
            }
#pragma unroll
        for (int ai = 0; ai < 2; ++ai)
#pragma unroll
            for (int m = 0; m < 4; ++m) {
                const size_t row = (size_t)(row0 + ai * HALF + m * 16);
                const unsigned long long* sl = (const unsigned long long*)(slots + row * 16 + fq * 4);
                const unsigned long long w0 = __hip_atomic_load(sl, __ATOMIC_RELAXED, __HIP_MEMORY_SCOPE_AGENT), w1 = __hip_atomic_load(sl + 1, __ATOMIC_RELAXED, __HIP_MEMORY_SCOPE_AGENT);
                float t = (__uint_as_float((unsigned)w0) + __uint_as_float((unsigned)(w0 >> 32))) + (__uint_as_float((unsigned)w1) + __uint_as_float((unsigned)(w1 >> 32)));
                t = rows4_sum(t);
                const float inv = rsqrtf(t * (1.0f / D) + 1e-6f);
#pragma unroll
                for (int bj = 0; bj < 2; ++bj) {
                    const f32x4 o0 = acc[ai][bj][m][0] * inv * sc[bj][0] + sh[bj][0], o1 = acc[ai][bj][m][1] * inv * sc[bj][1] + sh[bj][1];
                    u32x4 w; w.x = cvt_pk_bf16(o0[0], o0[1]); w.y = cvt_pk_bf16(o0[2], o0[3]); w.z = cvt_pk_bf16(o1[0], o1[1]); w.w = cvt_pk_bf16(o1[2], o1[3]);
                    *(u32x4*)(H2 + row * D + col0 + bj * HALF) = w;
                }
            }
    }
};

struct EpiSwiglu {
    static constexpr bool PERM = true, AFTER_DRAIN = false;
    bf16* H;
    __device__ __forceinline__ void operator()(const f32x4 (&acc)[2][2][4][2], const Unit& u, int wr, int wc, int fr, int fq) const {
        const int row0 = u.pm * 256 + wr * 64 + fr; const int col0 = u.pn * 128 + wc * 32 + 8 * fq;
#pragma unroll
        for (int ai = 0; ai < 2; ++ai)
#pragma unroll
            for (int m = 0; m < 4; ++m) {
                float o[8];
#pragma unroll
                for (int n = 0; n < 2; ++n)
#pragma unroll
                    for (int i = 0; i < 4; ++i) { const float a = acc[ai][0][m][n][i], b = acc[ai][1][m][n][i]; o[n * 4 + i] = a * sigmoidf_(a) * b; }
                u32x4 w; w.x = cvt_pk_bf16(o[0], o[1]); w.y = cvt_pk_bf16(o[2], o[3]); w.z = cvt_pk_bf16(o[4], o[5]); w.w = cvt_pk_bf16(o[6], o[7]);
                *(u32x4*)(H + (size_t)(row0 + ai * HALF + m * 16) * FF + col0) = w;
            }
    }
};

__device__ __forceinline__ void transpose_item(const float* __restrict__ W, int K, int N, bf16* WT, int mode, LAS float* scr, int item, int lane) {
    const int nblk = N / 32, kb = item / nblk, nb = item % nblk, k0 = 64 * kb, n0 = 32 * nb;
#pragma unroll 8
    for (int i = 0; i < 32; ++i) { const int kk = 2 * i + (lane >> 5); scr[kk * 33 + (lane & 31)] = W[(size_t)(k0 + kk) * N + n0 + (lane & 31)]; }
    LDS_WAIT();
    const int c = lane & 7;
#pragma unroll
    for (int j = 0; j < 4; ++j) {
        const int nn = (lane >> 3) + 8 * j; const LAS float* s = scr + (8 * c) * 33 + nn;
        u32x4 o; o.x = pk2(s[0 * 33], s[1 * 33]); o.y = pk2(s[2 * 33], s[3 * 33]); o.z = pk2(s[4 * 33], s[5 * 33]); o.w = pk2(s[6 * 33], s[7 * 33]);
        const int n = n0 + nn; const int drow = (mode == 0) ? n : ((n >> 7) * 256 + (mode == 2 ? 128 : 0) + (n & 127));
        *(u32x4*)(WT + (size_t)drow * K + k0 + 8 * c) = o;
    }
    LDS_WAIT();
}

struct P0Args { const float *w_in, *wa, *wb, *wout, *w1, *w3, *w2, *ada_w, *c, *decay_up, *iclr_up, *gate_up; unsigned char* ws; };

__device__ __forceinline__ void phase0(const P0Args& A, LAS unsigned char* lds, int gw, int NGW, int wave, int lane, int gt, int NGT) {
    LAS float* scr = (LAS float*)(lds + wave * 16384);
    constexpr int I_IN = 16 * 144, I_A = 8 * 32, I_O = 16 * 32, I_1 = 16 * 88, I_2 = 44 * 32, I_ADA = KSPLIT * 96;
    constexpr int NITEMS = I_IN + 2 * I_A + I_O + 2 * I_1 + I_2 + I_ADA;
    for (int it = gw; it < NITEMS; it += NGW) {
        int r = it;
        if (r < I_ADA) {
            const int ks = r / 96, cb = r % 96, col = cb * 64 + lane;
            float acc[8];
#pragma unroll
            for (int b = 0; b < 8; ++b) acc[b] = 0.f;
            for (int kk = 0; kk < 64; ++kk) {
                const int k = ks * 64 + kk; const float w = A.ada_w[(size_t)k * ADAW + col];
#pragma unroll
                for (int b = 0; b < 8; ++b) acc[b] += A.c[b * D + k] * w;
            }
            float* adap = (float*)(A.ws + WS_ADAP);
#pragma unroll
            for (int b = 0; b < 8; ++b) adap[(size_t)(ks * 8 + b) * ADAW + col] = acc[b];
            continue;
        }
        r -= I_ADA;
        if (r < I_IN) { transpose_item(A.w_in, D, INW, (bf16*)(A.ws + WS_WIN), 0, scr, r, lane); continue; } r -= I_IN;
        if (r < I_A) { transpose_item(A.wa, 512, D, (bf16*)(A.ws + WS_WA), 0, scr, r, lane); continue; } r -= I_A;
        if (r < I_A) { transpose_item(A.wb, 512, D, (bf16*)(A.ws + WS_WB), 0, scr, r, lane); continue; } r -= I_A;
        if (r < I_O) { transpose_item(A.wout, D, D, (bf16*)(A.ws + WS_WOUT), 0, scr, r, lane); continue; } r -= I_O;
        if (r < I_1) { transpose_item(A.w1, D, FF, (bf16*)(A.ws + WS_W13), 1, scr, r, lane); continue; } r -= I_1;
        if (r < I_1) { transpose_item(A.w3, D, FF, (bf16*)(A.ws + WS_W13), 2, scr, r, lane); continue; } r -= I_1;
        transpose_item(A.w2, FF, D, (bf16*)(A.ws + WS_W2), 0, scr, r, lane);
    }
    bf16* DUT = (bf16*)(A.ws + WS_DUT); bf16* IUT = (bf16*)(A.ws + WS_IUT); bf16* GUT = (bf16*)(A.ws + WS_GUT);
    for (int i = gt; i < 512 * 64; i += NGT) { const int ch = i >> 6, k = i & 63; const int d = ((((ch >> 4) * 2 + (k >> 5)) * 64 + ((k >> 3) & 3) * 16 + (ch & 15)) * 8 + (k & 7));
        DUT[d] = (bf16)f2bf(A.decay_up[k * 512 + ch]); IUT[d] = (bf16)f2bf(A.iclr_up[k * 512 + ch]); }
    for (int i = gt; i < 512 * 128; i += NGT) { const int ch = i >> 7, k = i & 127; const int d = ((((ch >> 4) * 4 + (k >> 5)) * 64 + ((k >> 3) & 3) * 16 + (ch & 15)) * 8 + (k & 7));
        GUT[d] = (bf16)f2bf(A.gate_up[k * 512 + ch]); }
}

template <bool PARTIALS>
__device__ __forceinline__ void norm_mod_phase(const float* X, const float* __restrict__ gain, const float* __restrict__ ada_b, const unsigned char* ws, int shift_off, int scale_off, bf16* H, int gw, int NGW, int lane) {
    const float* adap = (const float*)(ws + WS_ADAP); const float* ada = (const float*)(ws + WS_ADA);
    for (int blk = gw; blk < T / 16; blk += NGW) {
        const int r0 = blk * 16, b = r0 / SEQ;
        f32x4 sc[4], sh[4];
#pragma unroll
        for (int j = 0; j < 4; ++j) {
            const int c = 4 * lane + 256 * j;
            f32x4 s, h;
            if (PARTIALS) {
                s = *(const f32x4*)(ada_b + scale_off + c); h = *(const f32x4*)(ada_b + shift_off + c);
                for (int ks = 0; ks < KSPLIT; ++ks) { const float* p = adap + (size_t)(ks * 8 + b) * ADAW; s += *(const f32x4*)(p + scale_off + c); h += *(const f32x4*)(p + shift_off + c); }
            } else { s = *(const f32x4*)(ada + (size_t)b * ADAW + scale_off + c); h = *(const f32x4*)(ada + (size_t)b * ADAW + shift_off + c); }
            const f32x4 g = *(const f32x4*)(gain + c);
            sc[j] = g * (s + 1.0f); sh[j] = h;
        }
        f32x4 nv[4];
        { const f32x4* xr = (const f32x4*)(X + (size_t)r0 * D) + lane;
#pragma unroll
          for (int j = 0; j < 4; ++j) nv[j] = xr[64 * j]; }
        for (int rr = 0; rr < 16; ++rr) {
            const size_t row = (size_t)(r0 + rr);
            f32x4 v[4]; float ss = 0.f;
#pragma unroll
            for (int j = 0; j < 4; ++j) { v[j] = nv[j]; ss += (v[j].x * v[j].x + v[j].y * v[j].y) + (v[j].z * v[j].z + v[j].w * v[j].w); }
            { const f32x4* xr = (const f32x4*)(X + (size_t)(r0 + ((rr < 15) ? rr + 1 : 15)) * D) + lane;
#pragma unroll
              for (int j = 0; j < 4; ++j) nv[j] = xr[64 * j]; }
            const float inv = rsqrtf(wave_sum(ss) * (1.0f / D) + 1e-6f);
            unsigned long long* o8 = (unsigned long long*)(H + row * D) + lane;
#pragma unroll
            for (int j = 0; j < 4; ++j) {
                const f32x4 o = v[j] * inv * sc[j] + sh[j];
                o8[64 * j] = (unsigned long long)pk2(o.x, o.y) | ((unsigned long long)pk2(o.z, o.w) << 32);
            }
        }
    }
}

#ifndef REP_P3A
#define REP_P3A 1
#endif
struct P3Args { const bf16* Rb; const float *mu, *w0, *a0, *k_a, *r_k; unsigned char* ws; };

__device__ __forceinline__ void phase3(const P3Args& A, unsigned char* lds, int tid, int wave, int lane) {
    constexpr int AST = 264;
    bf16* ACT = (bf16*)lds;
    const bf16* DUT = (const bf16*)(A.ws + WS_DUT); const bf16* IUT = (const bf16*)(A.ws + WS_IUT); const bf16* GUT = (const bf16*)(A.ws + WS_GUT);
    bf16* Rr = (bf16*)(A.ws + WS_R); bf16* Kr = (bf16*)(A.ws + WS_K); bf16* Vr = (bf16*)(A.ws + WS_V);
    bf16* G = (bf16*)(A.ws + WS_HBUF); bf16* AH = (bf16*)(A.ws + WS_HBUF + 32 * MiB);
    float* LW = (float*)(A.ws + WS_LW); float* RK = (float*)(A.ws + WS_RK);
    const int fr0 = lane & 15, fq0 = lane >> 4;
    for (int blk = blockIdx.x; blk < T / 128; blk += gridDim.x) {
        const int t0 = blk * 128, b = t0 / SEQ, s0 = t0 % SEQ;
        __syncthreads();
#pragma unroll 1
        for (int rep = 0; rep < 8 * REP_P3A; ++rep) {
            const int task = tid + (rep & 7) * 512, tok = task >> 5, c8 = (task & 31) * 8, t = t0 + tok;
            const u32x4 pc = *(const u32x4*)(A.Rb + (size_t)t * RW + 1536 + c8);
            u32x4 pp = (u32x4){0u, 0u, 0u, 0u};
            if (t % SEQ) pp = *(const u32x4*)(A.Rb + (size_t)(t - 1) * RW + 1536 + c8);
            const f32x4 m0 = *(const f32x4*)(A.mu + 1536 + c8), m1 = *(const f32x4*)(A.mu + 1536 + c8 + 4);
            const unsigned pcw[4] = {pc.x, pc.y, pc.z, pc.w}, ppw[4] = {pp.x, pp.y, pp.z, pp.w};
            float x[8];
#pragma unroll
            for (int i = 0; i < 4; ++i) {
                const float c_lo = __uint_as_float(pcw[i] << 16), c_hi = __uint_as_float(pcw[i] & 0xffff0000u), p_lo = __uint_as_float(ppw[i] << 16), p_hi = __uint_as_float(ppw[i] & 0xffff0000u);
                const float mlo = (i < 2) ? m0[2 * i] : m1[2 * i - 4], mhi = (i < 2) ? m0[2 * i + 1] : m1[2 * i - 3];
                x[2 * i] = c_lo + (p_lo - c_lo) * mlo; x[2 * i + 1] = c_hi + (p_hi - c_hi) * mhi;
            }
            if (c8 < 64) {
#pragma unroll
                for (int i = 0; i < 8; ++i) { const float e = __expf(-2.0f * fabsf(x[i])); const float th = (1.0f - e) * __builtin_amdgcn_rcpf(1.0f + e); x[i] = copysignf(th, x[i]); }
            } else if (c8 >= 128) {
#pragma unroll
                for (int i = 0; i < 8; ++i) x[i] = sigmoidf_(x[i]);
            }
            *(u32x4*)(ACT + tok * AST + c8) = (u32x4){pk2(x[0], x[1]), pk2(x[2], x[3]), pk2(x[4], x[5]), pk2(x[6], x[7])};
        }
        __syncthreads();
        const size_t hb = ((size_t)(b * 8 + wave) * SEQ + s0) * 64;
        const bf16* __restrict__ Rbr = A.Rb;
        unsigned char* stg = lds + 67584 + wave * 7344;
        u32x4 rowreg[7];
#define P3_ROWLOAD(TT, LN) do { _Pragma("unroll") for (int j = 0; j < 7; ++j) { const int task = (LN) + 64 * j; const int arr = task / 136, rem = task - arr * 136, row = rem >> 3, c16 = rem & 7; \
            const int tq = t0 + (TT) * 16 + row - 1; const bool ok = (task < 408) && !(row == 0 && ((t0 + (TT) * 16) % SEQ) == 0); \
            rowreg[j] = (u32x4){0u, 0u, 0u, 0u}; if (ok) rowreg[j] = *(const u32x4*)(Rbr + (size_t)tq * RW + arr * 512 + wave * 64 + c16 * 8); } } while (0)
        { int zo0; asm volatile("v_mov_b32 %0, 0" : "=v"(zo0)); P3_ROWLOAD(0, lane + zo0); }
#pragma unroll 1
        for (int tt = 0; tt < 8; ++tt) {
            int zo; asm volatile("v_mov_b32 %0, 0" : "=v"(zo));
            const int fr = fr0 + zo, fq = fq0 + zo, ln = lane + zo;
            const int tl = tt * 16 + fr, t = t0 + tl;
#pragma unroll
            for (int j = 0; j < 7; ++j) { const int task = ln + 64 * j; const int arr = task / 136, rem = task - arr * 136, row = rem >> 3, c16 = rem & 7;
                if (task < 408) *(u32x4*)(stg + (arr * 17 + row) * 144 + c16 * 16) = rowreg[j]; }
            LDS_WAIT();
            const bf16* actp = ACT + (tt * 16 + fr) * AST + fq * 8;
            f32x4 lwo[4]; u32x2 ro[4], ko[4], vo[4], aho[4], go[4];
            const f32x4 zz = (f32x4){0.f, 0.f, 0.f, 0.f};
            bf16x8 Wd[2], Wi[2], Wg[4];
#pragma unroll
            for (int ks = 0; ks < 2; ++ks) { Wd[ks] = *(const bf16x8*)(DUT + (((wave * 4 + 0) * 2 + ks) * 64 + ln) * 8); Wi[ks] = *(const bf16x8*)(IUT + (((wave * 4 + 0) * 2 + ks) * 64 + ln) * 8); }
#pragma unroll
            for (int ks = 0; ks < 4; ++ks) Wg[ks] = *(const bf16x8*)(GUT + (((wave * 4 + 0) * 4 + ks) * 64 + ln) * 8);
#pragma unroll
            for (int ct = 0; ct < 4; ++ct) {
                const int c4 = ct * 16 + fq * 4, ch = wave * 64 + c4;
                f32x4 ad = zz, ai = zz, ag = zz;
#pragma unroll
                for (int ks = 0; ks < 2; ++ks) {
                    ad = __builtin_amdgcn_mfma_f32_16x16x32_bf16(Wd[ks], *(const bf16x8*)(actp + ks * 32), ad, 0, 0, 0);
                    ai = __builtin_amdgcn_mfma_f32_16x16x32_bf16(Wi[ks], *(const bf16x8*)(actp + 64 + ks * 32), ai, 0, 0, 0);
                }
#pragma unroll
                for (int ks = 0; ks < 4; ++ks) ag = __builtin_amdgcn_mfma_f32_16x16x32_bf16(Wg[ks], *(const bf16x8*)(actp + 128 + ks * 32), ag, 0, 0, 0);
                if (ct < 3) {
#pragma unroll
                    for (int ks = 0; ks < 2; ++ks) { Wd[ks] = *(const bf16x8*)(DUT + (((wave * 4 + ct + 1) * 2 + ks) * 64 + ln) * 8); Wi[ks] = *(const bf16x8*)(IUT + (((wave * 4 + ct + 1) * 2 + ks) * 64 + ln) * 8); }
#pragma unroll
                    for (int ks = 0; ks < 4; ++ks) Wg[ks] = *(const bf16x8*)(GUT + (((wave * 4 + ct + 1) * 4 + ks) * 64 + ln) * 8);
                }
                const f32x4 w0 = *(const f32x4*)(A.w0 + ch), a0 = *(const f32x4*)(A.a0 + ch), ka = *(const f32x4*)(A.k_a + ch), rk = *(const f32x4*)(A.r_k + ch);
                const f32x4 mur = *(const f32x4*)(A.mu + ch), muk = *(const f32x4*)(A.mu + 512 + ch), muv = *(const f32x4*)(A.mu + 1024 + ch);
                const unsigned char* rs = stg + fr * 144 + c4 * 2;
                const f32x4 r0 = bf4(*(const u32x2*)(rs)), r1 = bf4(*(const u32x2*)(rs + 144));
                const f32x4 k0 = bf4(*(const u32x2*)(rs + 17 * 144)), k1 = bf4(*(const u32x2*)(rs + 18 * 144));
                const f32x4 v0 = bf4(*(const u32x2*)(rs + 34 * 144)), v1 = bf4(*(const u32x2*)(rs + 35 * 144));
                const f32x4 rm = r1 + (r0 - r1) * mur, km = k1 + (k0 - k1) * muk, vm = v1 + (v0 - v1) * muv;
                f32x4 lw, ah;
#pragma unroll
                for (int r = 0; r < 4; ++r) { lw[r] = -0.6065306597f * sigmoidf_(w0[r] + ad[r]); ah[r] = sigmoidf_(a0[r] + ai[r]); }
                const f32x4 kp = km * ((ah - 1.0f) * ka + 1.0f);
                const f32x4 pr3 = rm * kp * rk;
                float rks = (pr3[0] + pr3[1]) + (pr3[2] + pr3[3]);
                rks = rows4_sum(rks);
                if (fq == 0) RK[((size_t)t * 8 + wave) * 4 + ct] = rks;
                lwo[ct] = lw;
                ro[ct] = (u32x2){pk2(rm[0], rm[1]), pk2(rm[2], rm[3])}; ko[ct] = (u32x2){pk2(km[0], km[1]), pk2(km[2], km[3])};
                vo[ct] = (u32x2){pk2(vm[0], vm[1]), pk2(vm[2], vm[3])}; aho[ct] = (u32x2){pk2(ah[0], ah[1]), pk2(ah[2], ah[3])};
                go[ct] = (u32x2){pk2(ag[0], ag[1]), pk2(ag[2], ag[3])};
                asm volatile("" ::: "memory");
            }
            P3_ROWLOAD((tt < 7) ? tt + 1 : 7, ln);
            LDS_WAIT();
            const size_t ob = hb + (size_t)(tt * 16) * 64;
#define P3_STAGE_BF16(ARR, SRC) do { \
                _Pragma("unroll") for (int ct = 0; ct < 4; ++ct) *(u32x2*)(stg + fr * 144 + (ct * 16 + fq * 4) * 2) = SRC[ct]; \
                LDS_WAIT(); \
                _Pragma("unroll") for (int j = 0; j < 2; ++j) { const int tk = (ln >> 3) + 8 * j, c16 = ln & 7; \
                    const u32x4 v = *(const u32x4*)(stg + tk * 144 + c16 * 16); *(u32x4*)(ARR + ob + (size_t)tk * 64 + c16 * 8) = v; } \
                LDS_WAIT(); } while (0)
            P3_STAGE_BF16(Rr, ro); P3_STAGE_BF16(Kr, ko); P3_STAGE_BF16(Vr, vo); P3_STAGE_BF16(AH, aho); P3_STAGE_BF16(G, go);
#undef P3_STAGE_BF16
            {
#pragma unroll
                for (int ct = 0; ct < 4; ++ct) *(f32x4*)(stg + fr * 272 + (ct * 16 + fq * 4) * 4) = lwo[ct];
                LDS_WAIT();
#pragma unroll
                for (int j = 0; j < 4; ++j) { const int tk = (ln >> 4) + 4 * j, c4 = (ln & 15) * 4;
                    const f32x4 v = *(const f32x4*)(stg + tk * 272 + c4 * 4); *(f32x4*)(LW + ob + (size_t)tk * 64 + c4) = v; }
                LDS_WAIT();
            }
        }
#undef P3_ROWLOAD
    }
}

struct PAArgs { const float *k_k, *k_a; unsigned char* ws; unsigned char* dout; };
constexpr int MST = 72;
constexpr int MBYTES = 64 * MST * 2;

__device__ __forceinline__ void mm2(const bf16* A, const bf16* Bt, int ti, int tj0, int fr, int fq, f32x4& c0, f32x4& c1) {
#pragma unroll
    for (int ks = 0; ks < 2; ++ks) {
        const bf16x8 a = *(const bf16x8*)(A + (ti * 16 + fr) * MST + ks * 32 + fq * 8);
        const bf16x8 b0 = *(const bf16x8*)(Bt + (tj0 * 16 + fr) * MST + ks * 32 + fq * 8);
        const bf16x8 b1 = *(const bf16x8*)(Bt + (tj0 * 16 + 16 + fr) * MST + ks * 32 + fq * 8);
        c0 = __builtin_amdgcn_mfma_f32_16x16x32_bf16(a, b0, c0, 0, 0, 0);
        c1 = __builtin_amdgcn_mfma_f32_16x16x32_bf16(a, b1, c1, 0, 0, 0);
    }
}

struct ChunkRaw { float lwv[8]; bf16 rb[8], kb[8], vb[8], ab[8]; };
__device__ __forceinline__ void chunk_load(const PAArgs& A, int item, int wave, int lane, ChunkRaw& R) {
    const bf16* Rr = (const bf16*)(A.ws + WS_R); const bf16* Kr = (const bf16*)(A.ws + WS_K); const bf16* Vr = (const bf16*)(A.ws + WS_V);
    const bf16* AH = (const bf16*)(A.ws + WS_HBUF + 32 * MiB); const float* LW = (const float*)(A.ws + WS_LW);
    const int bh = item >> 6, ck = item & 63;
#pragma unroll
    for (int i = 0; i < 8; ++i) {
        const size_t o = ((size_t)bh * SEQ + ck * 64 + wave * 8 + i) * 64 + lane;
        R.lwv[i] = LW[o]; R.rb[i] = Rr[o]; R.kb[i] = Kr[o]; R.vb[i] = Vr[o]; R.ab[i] = AH[o];
    }
}
__device__ __forceinline__ void chunk_item(const PAArgs& A, unsigned char* lds, int item, int tid, int wave, int lane, const ChunkRaw& RAW) {
    bf16* AT = (bf16*)(lds + 0 * MBYTES); bf16* BT = (bf16*)(lds + 1 * MBYTES); bf16* KT = (bf16*)(lds + 2 * MBYTES); bf16* RT = (bf16*)(lds + 3 * MBYTES);
    bf16* BHT = (bf16*)(lds + 4 * MBYTES); bf16* KHT = (bf16*)(lds + 5 * MBYTES); bf16* VT = (bf16*)(lds + 6 * MBYTES);
    bf16* AAK = (bf16*)(lds + 7 * MBYTES); bf16* ARB = (bf16*)(lds + 8 * MBYTES); bf16* ARK = (bf16*)(lds + 9 * MBYTES);
    bf16* X1T = (bf16*)(lds + 10 * MBYTES); bf16* ZT = (bf16*)(lds + 11 * MBYTES);
    bf16* ATT = (bf16*)(lds + 12 * MBYTES); bf16* AVT = (bf16*)(lds + 13 * MBYTES); bf16* AABb = (bf16*)(lds + 14 * MBYTES);
    float* Dg = (float*)(lds + 15 * MBYTES);
    constexpr int TST = 20; bf16* Tinv = (bf16*)(lds + 15 * MBYTES + 4096);
    float* WCs = (float*)(lds + 15 * MBYTES + 4096 + 2560); float* CUMT = Dg;
    const bf16* Rr = (const bf16*)(A.ws + WS_R); const bf16* Kr = (const bf16*)(A.ws + WS_K); const bf16* Vr = (const bf16*)(A.ws + WS_V);
    const bf16* AH = (const bf16*)(A.ws + WS_HBUF + 32 * MiB); const float* LW = (const float*)(A.ws + WS_LW);
    float* Qg = (float*)(A.dout + DO_QG) + (size_t)item * 4096; bf16* Y0g = (bf16*)(A.dout + DO_Y0) + (size_t)item * 4096;
    bf16* RPg = (bf16*)(A.dout + DO_RP) + (size_t)item * 4096; bf16* Pg = (bf16*)(A.ws + WS_PG) + (size_t)item * 4096;
    const int bh = item >> 6, ck = item & 63, b = bh >> 3, h = bh & 7;
    const size_t tok0 = (size_t)b * SEQ + ck * 64;
    const int fr = lane & 15, fq = lane >> 4;
    LBAR();
    {
        const int ch = lane, tg = wave;
        float lwv[8], rv[8], kv[8], av[8], pl[8]; bf16 vb[8];
        float run = 0.f;
#pragma unroll
        for (int i = 0; i < 8; ++i) {
            lwv[i] = RAW.lwv[i]; rv[i] = bf2f(RAW.rb[i]); kv[i] = bf2f(RAW.kb[i]); vb[i] = RAW.vb[i]; av[i] = bf2f(RAW.ab[i]);
            run += lwv[i]; pl[i] = run;
        }
        CUMT[tg * 64 + ch] = run;
        LBAR();
        float off = 0.f, tot = 0.f;
#pragma unroll
        for (int g = 0; g < 8; ++g) { const float c = CUMT[g * 64 + ch]; tot += c; off += (g < tg) ? c : 0.f; }
        const float kkc = A.k_k[h * 64 + ch], kac = A.k_a[h * 64 + ch];
        const float etot = __expf(tot);
        unsigned bhp[4], khp[4], vp[4];
        float bhv[8], khv[8], atv[8];
#pragma unroll
        for (int i = 0; i < 8; ++i) {
            const float cl = off + pl[i], clp = cl - lwv[i];
            const float kq = kv[i] * kkc;
            const float kk = kq * __builtin_amdgcn_rsqf(fmaxf(wave_sum(kq * kq), 1e-24f));
            const float a_ = -kk, b_ = kk * av[i], kp = kv[i] * (1.0f + (av[i] - 1.0f) * kac);
            const float ecl = __expf(cl), encl = __builtin_amdgcn_rcpf(ecl), eclp = __expf(clp), eh = etot * encl;
            const int tok = tg * 8 + i;
            atv[i] = a_ * eclp; AT[tok * MST + ch] = (bf16)f2bf(a_ * eclp); BT[tok * MST + ch] = (bf16)f2bf(b_ * encl); KT[tok * MST + ch] = (bf16)f2bf(kp * encl); RT[tok * MST + ch] = (bf16)f2bf(rv[i] * ecl);
            bhv[i] = b_ * eh; khv[i] = kp * eh;
        }
#pragma unroll
        for (int i = 0; i < 4; ++i) { bhp[i] = pk2(bhv[2 * i], bhv[2 * i + 1]); khp[i] = pk2(khv[2 * i], khv[2 * i + 1]); vp[i] = (unsigned)vb[2 * i] | ((unsigned)vb[2 * i + 1] << 16); }
        *(u32x4*)(BHT + ch * MST + tg * 8) = (u32x4){bhp[0], bhp[1], bhp[2], bhp[3]};
        *(u32x4*)(KHT + ch * MST + tg * 8) = (u32x4){khp[0], khp[1], khp[2], khp[3]};
        *(u32x4*)(VT + ch * MST + tg * 8) = (u32x4){vp[0], vp[1], vp[2], vp[3]};
        *(u32x4*)(ATT + ch * MST + tg * 8) = (u32x4){pk2(atv[0], atv[1]), pk2(atv[2], atv[3]), pk2(atv[4], atv[5]), pk2(atv[6], atv[7])};
        if (tg == 0) WCs[ch] = etot;
    }
    LBAR();
    const int ti = wave >> 1, tj0 = (wave & 1) * 2;
    const f32x4 z4 = (f32x4){0.f, 0.f, 0.f, 0.f};
    {
        f32x4 c0 = z4, c1 = z4;
        const int jb = ti * 16 + fq * 4;
        const int ta = tj0 * 16 + fr, tb = ta + 16;
#define S3_MASK(c, t, INCL) (f32x4){ (jb + 0 < (t) + (INCL)) ? c[0] : 0.f, (jb + 1 < (t) + (INCL)) ? c[1] : 0.f, (jb + 2 < (t) + (INCL)) ? c[2] : 0.f, (jb + 3 < (t) + (INCL)) ? c[3] : 0.f }
        mm2(BT, AT, ti, tj0, fr, fq, c0, c1);
        { const f32x4 m0 = S3_MASK(c0, ta, 0), m1 = S3_MASK(c1, tb, 0);
          *(u32x2*)(AABb + ta * MST + jb) = (u32x2){pk2(m0[0], m0[1]), pk2(m0[2], m0[3])}; *(u32x2*)(AABb + tb * MST + jb) = (u32x2){pk2(m1[0], m1[1]), pk2(m1[2], m1[3])};
          if (tj0 == ti) *(f32x4*)(Dg + (ti * 16 + fr) * 16 + fq * 4) = m0;
          if (tj0 + 1 == ti) *(f32x4*)(Dg + (ti * 16 + fr) * 16 + fq * 4) = m1; }
        c0 = z4; c1 = z4; mm2(KT, AT, ti, tj0, fr, fq, c0, c1);
        { const f32x4 m0 = S3_MASK(c0, ta, 0), m1 = S3_MASK(c1, tb, 0);
          *(u32x2*)(AAK + ta * MST + jb) = (u32x2){pk2(m0[0], m0[1]), pk2(m0[2], m0[3])}; *(u32x2*)(AAK + tb * MST + jb) = (u32x2){pk2(m1[0], m1[1]), pk2(m1[2], m1[3])}; }
        c0 = z4; c1 = z4; mm2(BT, RT, ti, tj0, fr, fq, c0, c1);
        { const f32x4 m0 = S3_MASK(c0, ta, 1), m1 = S3_MASK(c1, tb, 1);
          *(u32x2*)(ARB + ta * MST + jb) = (u32x2){pk2(m0[0], m0[1]), pk2(m0[2], m0[3])}; *(u32x2*)(ARB + tb * MST + jb) = (u32x2){pk2(m1[0], m1[1]), pk2(m1[2], m1[3])}; }
        c0 = z4; c1 = z4; mm2(KT, RT, ti, tj0, fr, fq, c0, c1);
        { const f32x4 m0 = S3_MASK(c0, ta, 1), m1 = S3_MASK(c1, tb, 1);
          *(u32x2*)(ARK + ta * MST + jb) = (u32x2){pk2(m0[0], m0[1]), pk2(m0[2], m0[3])}; *(u32x2*)(ARK + tb * MST + jb) = (u32x2){pk2(m1[0], m1[1]), pk2(m1[2], m1[3])}; }
#undef S3_MASK
    }
    LBAR();
    {
        f32x4 c0 = z4, c1 = z4;
        mm2(AAK, VT, ti, tj0, fr, fq, c0, c1);
        *(u32x2*)(AVT + (tj0 * 16 + fr) * MST + ti * 16 + fq * 4) = (u32x2){pk2(c0[0], c0[1]), pk2(c0[2], c0[3])};
        *(u32x2*)(AVT + (tj0 * 16 + 16 + fr) * MST + ti * 16 + fq * 4) = (u32x2){pk2(c1[0], c1[1]), pk2(c1[2], c1[3])};
        if (wave == 0) {
            const int bi = lane >> 4, cc = lane & 15;
            float t[16];
#pragma unroll
            for (int r = 0; r < 16; ++r) {
                float acc = (r == cc) ? 1.f : 0.f;
#pragma unroll
                for (int k = 0; k < r; ++k) acc += Dg[(bi * 16 + r) * 16 + k] * t[k];
                t[r] = acc;
            }
#pragma unroll
            for (int r = 0; r < 16; ++r) Tinv[(bi * 16 + r) * TST + cc] = (bf16)f2bf(t[r]);
        }
    }
    LBAR();
    {
        typedef short s16x4 __attribute__((ext_vector_type(4)));
        const int cb = (wave & 3) * 16 + fr;
        const bf16* src = (wave < 4 ? ATT : AVT) + cb * MST;
        bf16* dst = (wave < 4 ? X1T : ZT) + cb * MST;
        s16x4 xb[4];
#pragma unroll
        for (int bi = 0; bi < 4; ++bi) {
            f32x4 acc = bf4(*(const u32x2*)(src + bi * 16 + fq * 4));
#pragma unroll
            for (int bj = 0; bj < bi; ++bj) acc = __builtin_amdgcn_mfma_f32_16x16x16bf16_1k(*(const s16x4*)(AABb + (bi * 16 + fr) * MST + bj * 16 + fq * 4), xb[bj], acc, 0, 0, 0);
            const u32x2 tb = (u32x2){pk2(acc[0], acc[1]), pk2(acc[2], acc[3])};
            const f32x4 xv = __builtin_amdgcn_mfma_f32_16x16x16bf16_1k(*(const s16x4*)(Tinv + (bi * 16 + fr) * TST + fq * 4), __builtin_bit_cast(s16x4, tb), z4, 0, 0, 0);
            const u32x2 xw = (u32x2){pk2(xv[0], xv[1]), pk2(xv[2], xv[3])};
            xb[bi] = __builtin_bit_cast(s16x4, xw);
            *(u32x2*)(dst + bi * 16 + fq * 4) = xw;
        }
    }
    LBAR();
    {
        f32x4 c0, c1;
        const int fl = lane * 4;
        { const u32x2 w0 = *(const u32x2*)(RT + (tj0 * 16 + fr) * MST + ti * 16 + fq * 4), w1 = *(const u32x2*)(RT + (tj0 * 16 + 16 + fr) * MST + ti * 16 + fq * 4);
          c0 = (f32x4){__uint_as_float(w0.x << 16), __uint_as_float(w0.x & 0xffff0000u), __uint_as_float(w0.y << 16), __uint_as_float(w0.y & 0xffff0000u)};
          c1 = (f32x4){__uint_as_float(w1.x << 16), __uint_as_float(w1.x & 0xffff0000u), __uint_as_float(w1.y << 16), __uint_as_float(w1.y & 0xffff0000u)}; }
        mm2(X1T, ARB, ti, tj0, fr, fq, c0, c1);
        const int fpos = (((ti >> 1) * 64) + ((ti & 1) * 2 + (fq >> 1)) * 16 + fr) * 8 + (fq & 1) * 4;
        *(u32x2*)(RPg + tj0 * 1024 + fpos) = (u32x2){pk2(c0[0], c0[1]), pk2(c0[2], c0[3])};
        *(u32x2*)(RPg + (tj0 + 1) * 1024 + fpos) = (u32x2){pk2(c1[0], c1[1]), pk2(c1[2], c1[3])};
        c0 = z4; c1 = z4; mm2(ZT, ARB, ti, tj0, fr, fq, c0, c1); mm2(VT, ARK, ti, tj0, fr, fq, c0, c1);
        *(u32x2*)(Y0g + (ti * 4 + tj0) * 256 + fl) = (u32x2){pk2(c0[0], c0[1]), pk2(c0[2], c0[3])};
        *(u32x2*)(Y0g + (ti * 4 + tj0 + 1) * 256 + fl) = (u32x2){pk2(c1[0], c1[1]), pk2(c1[2], c1[3])};
        c0 = z4; c1 = z4; mm2(X1T, BHT, ti, tj0, fr, fq, c0, c1);
        { const int chp = ti * 16 + fq * 4, cha = tj0 * 16 + fr, chb = cha + 16; const float wa = WCs[cha], wb = WCs[chb];
#pragma unroll
          for (int r = 0; r < 4; ++r) { c0[r] += (chp + r == cha) ? wa : 0.f; c1[r] += (chp + r == chb) ? wb : 0.f; }
          *(u32x2*)(Pg + tj0 * 1024 + fpos) = (u32x2){pk2(c0[0], c0[1]), pk2(c0[2], c0[3])};
          *(u32x2*)(Pg + (tj0 + 1) * 1024 + fpos) = (u32x2){pk2(c1[0], c1[1]), pk2(c1[2], c1[3])}; }
        c0 = z4; c1 = z4; mm2(BHT, ZT, ti, tj0, fr, fq, c0, c1); mm2(KHT, VT, ti, tj0, fr, fq, c0, c1);
        *(f32x4*)(Qg + (ti * 4 + tj0) * 256 + fl) = c0;
        *(f32x4*)(Qg + (ti * 4 + tj0 + 1) * 256 + fl) = c1;
    }
}

struct PBArgs { const float *lnx_g, *lnx_b; unsigned char* ws; unsigned char* dout; };

__device__ __forceinline__ void chunk_scan_m(const PBArgs& A, unsigned char* lds, int bh, int tid, int wave, int lane) {
    const float* Qg = (const float*)(A.dout + DO_QG); const bf16* Pg = (const bf16*)(A.ws + WS_PG);
    bf16* MC = (bf16*)(A.ws + WS_MC);
    const int fr = lane & 15, fq = lane >> 4, ti = wave >> 1, vj0 = (wave & 1) * 2;
    for (int i = tid; i < 64 * MST; i += 512) ((bf16*)lds)[i] = 0;
    const size_t item0 = (size_t)bh * 64;
    for (int i = tid; i < 512; i += 512) *(u32x4*)(MC + item0 * 4096 + (size_t)i * 8) = (u32x4){0u, 0u, 0u, 0u};
    LBAR();
    constexpr int PF = 4;
    bf16x8 aS[PF][2]; f32x4 cS[PF][2];
#pragma unroll
    for (int s = 0; s < PF; ++s) {
        const size_t it = (item0 + s) * 4096;
#pragma unroll
        for (int ks = 0; ks < 2; ++ks) aS[s][ks] = *(const bf16x8*)(Pg + it + ((ti * 2 + ks) * 64 + lane) * 8);
#pragma unroll
        for (int j = 0; j < 2; ++j) cS[s][j] = *(const f32x4*)(Qg + it + (ti * 4 + vj0 + j) * 256 + lane * 4);
    }
    const int fks = ti >> 1, ffq = (ti & 1) * 2 + (fq >> 1), fhalf = fq & 1;
    for (int ck0 = 0; ck0 < 64; ck0 += PF) {
#pragma unroll
        for (int s = 0; s < PF; ++s) {
            const int ck = ck0 + s;
            const bf16* cur = (const bf16*)(lds + (ck & 1) * MBYTES); bf16* nxt = (bf16*)(lds + ((ck + 1) & 1) * MBYTES);
            f32x4 c[2];
#pragma unroll
            for (int j = 0; j < 2; ++j) {
                c[j] = cS[s][j];
#pragma unroll
                for (int ks = 0; ks < 2; ++ks) c[j] = __builtin_amdgcn_mfma_f32_16x16x32_bf16(aS[s][ks], *(const bf16x8*)(cur + ((vj0 + j) * 16 + fr) * MST + ks * 32 + fq * 8), c[j], 0, 0, 0);
            }
            {
                const int ckn = (ck + PF < 64) ? ck + PF : 63;
                const size_t it = (item0 + ckn) * 4096;
#pragma unroll
                for (int ks = 0; ks < 2; ++ks) aS[s][ks] = *(const bf16x8*)(Pg + it + ((ti * 2 + ks) * 64 + lane) * 8);
#pragma unroll
                for (int j = 0; j < 2; ++j) cS[s][j] = *(const f32x4*)(Qg + it + (ti * 4 + vj0 + j) * 256 + lane * 4);
            }
#pragma unroll
            for (int j = 0; j < 2; ++j) {
                const u32x2 w = (u32x2){pk2(c[j][0], c[j][1]), pk2(c[j][2], c[j][3])};
                *(u32x2*)(nxt + ((vj0 + j) * 16 + fr) * MST + ti * 16 + fq * 4) = w;
                if (ck < 63) *(u32x2*)(MC + (item0 + ck + 1) * 4096 + ((((vj0 + j) * 2 + fks) * 64 + ffq * 16 + fr) * 8 + fhalf * 4)) = w;
            }
            LBAR();
        }
    }
}

__device__ __forceinline__ void chunk_out(const PBArgs& A, unsigned char* lds, int G_, int wave, int lane) {
    const bf16* Y0g = (const bf16*)(A.dout + DO_Y0); const bf16* RPg = (const bf16*)(A.dout + DO_RP); const bf16* MC = (const bf16*)(A.ws + WS_MC);
    const bf16* Vr = (const bf16*)(A.ws + WS_V); const bf16* Gt = (const bf16*)(A.ws + WS_HBUF); const float* RK = (const float*)(A.ws + WS_RK);
    bf16* YA = (bf16*)(A.ws + WS_YA);
    const int fr = lane & 15, fq = lane >> 4, tt = wave & 3, half = wave >> 2;
    unsigned char* ostg = lds + wave * 2304;
    bf16x8 nbR[2], naM[4][2]; u32x2 ny0[4]; u32x4 nrv[2], nrg[2]; f32x4 nr4;
#define CO_LOAD(IT) do { const int it_ = (IT); const int bh_ = it_ >> 6, ck_ = it_ & 63; const size_t ib_ = (size_t)it_ * 4096; \
        _Pragma("unroll") for (int ks = 0; ks < 2; ++ks) nbR[ks] = *(const bf16x8*)(RPg + ib_ + ((tt * 2 + ks) * 64 + lane) * 8); \
        _Pragma("unroll") for (int vi = 0; vi < 4; ++vi) { _Pragma("unroll") for (int ks = 0; ks < 2; ++ks) naM[vi][ks] = *(const bf16x8*)(MC + ib_ + ((vi * 2 + ks) * 64 + lane) * 8); \
            ny0[vi] = *(const u32x2*)(Y0g + ib_ + (vi * 4 + tt) * 256 + lane * 4); } \
        const size_t rbase_ = ((size_t)bh_ * SEQ + ck_ * 64 + tt * 16) * 64; \
        _Pragma("unroll") for (int j = 0; j < 2; ++j) { const int tk = (lane >> 3) + 8 * j, c16 = lane & 7; nrv[j] = *(const u32x4*)(Vr + rbase_ + (size_t)tk * 64 + c16 * 8); nrg[j] = *(const u32x4*)(Gt + rbase_ + (size_t)tk * 64 + c16 * 8); } \
        nr4 = *(const f32x4*)(RK + ((((size_t)(bh_ >> 3) * SEQ + ck_ * 64 + tt * 16 + fr) * 8 + (bh_ & 7)) * 4)); } while (0)
    const int it0 = blockIdx.x * 2 + half;
    if (it0 < 4096) CO_LOAD(it0);
    for (int it = it0; it < 4096; it += 2 * G_) {
        const int bh = it >> 6, ck = it & 63, b = bh >> 3, h = bh & 7;
        bf16x8 bR[2], aM[4][2]; u32x2 y0[4], vv[4], gg[4]; u32x4 rv[2], rg[2];
#pragma unroll
        for (int ks = 0; ks < 2; ++ks) bR[ks] = nbR[ks];
#pragma unroll
        for (int vi = 0; vi < 4; ++vi) { aM[vi][0] = naM[vi][0]; aM[vi][1] = naM[vi][1]; y0[vi] = ny0[vi]; }
#pragma unroll
        for (int j = 0; j < 2; ++j) { rv[j] = nrv[j]; rg[j] = nrg[j]; }
        const float rk = (nr4[0] + nr4[1]) + (nr4[2] + nr4[3]);
        {
#pragma unroll
            for (int j = 0; j < 2; ++j) { const int tk = (lane >> 3) + 8 * j, c16 = lane & 7; *(u32x4*)(ostg + tk * 144 + c16 * 16) = rv[j]; }
            LDS_WAIT();
#pragma unroll
            for (int vi = 0; vi < 4; ++vi) vv[vi] = *(const u32x2*)(ostg + fr * 144 + (vi * 16 + fq * 4) * 2);
            LDS_WAIT();
#pragma unroll
            for (int j = 0; j < 2; ++j) { const int tk = (lane >> 3) + 8 * j, c16 = lane & 7; *(u32x4*)(ostg + tk * 144 + c16 * 16) = rg[j]; }
            LDS_WAIT();
#pragma unroll
            for (int vi = 0; vi < 4; ++vi) gg[vi] = *(const u32x2*)(ostg + fr * 144 + (vi * 16 + fq * 4) * 2);
            LDS_WAIT();
        }
        f32x4 c[4];
#pragma unroll
        for (int vi = 0; vi < 4; ++vi) {
            c[vi] = bf4(y0[vi]);
#pragma unroll
            for (int ks = 0; ks < 2; ++ks) c[vi] = __builtin_amdgcn_mfma_f32_16x16x32_bf16(aM[vi][ks], bR[ks], c[vi], 0, 0, 0);
        }
        { const int itn = (it + 2 * G_ < 4096) ? it + 2 * G_ : it; CO_LOAD(itn); }
        float sm = 0.f;
#pragma unroll
        for (int vi = 0; vi < 4; ++vi) sm += (c[vi][0] + c[vi][1]) + (c[vi][2] + c[vi][3]);
        sm = rows4_sum(sm);
        const float mu = sm * (1.0f / 64.0f);
        float q = 0.f;
#pragma unroll
        for (int vi = 0; vi < 4; ++vi) { c[vi] = c[vi] - mu; q += (c[vi][0] * c[vi][0] + c[vi][1] * c[vi][1]) + (c[vi][2] * c[vi][2] + c[vi][3] * c[vi][3]); }
        q = rows4_sum(q);
        const float rs = rsqrtf(q * (1.0f / 64.0f) + 64e-5f);
#pragma unroll
        for (int vi = 0; vi < 4; ++vi) {
            const f32x4 lg = *(const f32x4*)(A.lnx_g + h * 64 + vi * 16 + fq * 4), lb = *(const f32x4*)(A.lnx_b + h * 64 + vi * 16 + fq * 4);
            const f32x4 o = (c[vi] * rs * lg + lb + bf4(vv[vi]) * rk) * bf4(gg[vi]);
            *(u32x2*)(ostg + fr * 144 + (vi * 16 + fq * 4) * 2) = (u32x2){pk2(o[0], o[1]), pk2(o[2], o[3])};
        }
        LDS_WAIT();
#pragma unroll
        for (int j = 0; j < 2; ++j) {
            const int tk = (lane >> 3) + 8 * j, c16 = lane & 7;
            const size_t tg = (size_t)b * SEQ + ck * 64 + tt * 16 + tk;
            *(u32x4*)(YA + tg * 512 + h * 64 + c16 * 8) = *(const u32x4*)(ostg + tk * 144 + c16 * 16);
        }
        LDS_WAIT();
    }
#undef CO_LOAD
}

struct AtArgs { const float *qg, *kg, *sinks; const int* pos; unsigned char* ws; };

__device__ __forceinline__ void rope_entry(int pos, int j, float& cs, float& sn) {
    const double fr[8] = {0.15915494309189535, 0.03086376340470123, 0.005985185712713705, 0.001160663641240061, 0.00022507907903927653, 4.364795279280289e-05, 8.464330808241401e-06, 1.6414262627950345e-06};
    double f0 = fr[0];
#pragma unroll
    for (int i = 1; i < 8; ++i) f0 = (j == i) ? fr[i] : f0;
    const double tt = (double)pos * f0;
    const float f = (float)(tt - __builtin_floor(tt));
    sn = __builtin_amdgcn_sinf(f); cs = __builtin_amdgcn_cosf(f);
}
__device__ __forceinline__ void rope16(float* x, const float* rp) {
    const f32x4 c0 = *(const f32x4*)rp, c1 = *(const f32x4*)(rp + 4), s0 = *(const f32x4*)(rp + 8), s1 = *(const f32x4*)(rp + 12);
#pragma unroll
    for (int i = 0; i < 8; ++i) {
        const float cs = (i < 4) ? c0[i & 3] : c1[i & 3], sn = (i < 4) ? s0[i & 3] : s1[i & 3];
        const float x1 = x[i], x2 = x[8 + i];
        x[i] = x1 * cs - x2 * sn; x[8 + i] = x2 * cs + x1 * sn;
    }
}
__device__ __forceinline__ void norm_rope(u32x4 w0, u32x4 w1, const float* __restrict__ gain, int chunk, const float* rp, float scale, float* x) {
    const unsigned ww[8] = {w0.x, w0.y, w0.z, w0.w, w1.x, w1.y, w1.z, w1.w};
    float ss = 0.f;
#pragma unroll
    for (int i = 0; i < 8; ++i) { x[2 * i] = __uint_as_float(ww[i] << 16); x[2 * i + 1] = __uint_as_float(ww[i] & 0xffff0000u); ss += x[2 * i] * x[2 * i] + x[2 * i + 1] * x[2 * i + 1]; }
    ss += dpp_perm<0xB1, 0xF>(ss); ss += dpp_perm<0x4E, 0xF>(ss);
    const float inv = rsqrtf(ss * (1.0f / 64.0f) + 1e-6f);
#pragma unroll
    for (int i = 0; i < 16; ++i) x[i] = x[i] * inv * gain[chunk * 16 + i];
    if (chunk == 0) rope16(x, rp);
#pragma unroll
    for (int i = 0; i < 16; ++i) x[i] *= scale;
}
__device__ __forceinline__ void load_norm_rope(const bf16* p, bool valid, const float* __restrict__ gain, int chunk, const float* rp, float scale, float* x) {
    u32x4 w0 = (u32x4){0, 0, 0, 0}, w1 = w0;
    if (valid) { w0 = *(const u32x4*)p; w1 = *(const u32x4*)(p + 8); }
    norm_rope(w0, w1, gain, chunk, rp, scale, x);
}

__device__ __forceinline__ void attn_unit(const AtArgs& A, unsigned char* lds, int unit, int tid, int wave, int lane) {
    constexpr int KST = 72, VST = 344, PST = 168, QST = 72;
    bf16* KS = (bf16*)lds;
    bf16* VT = (bf16*)(lds + 36864);
    bf16* PS = (bf16*)(lds + 36864 + 44032) + wave * 16 * PST;
    bf16* QS = (bf16*)(lds + 36864 + 44032 + 8 * 16 * PST * 2) + wave * 16 * QST;
    const bf16* Q = (const bf16*)(A.ws + WS_QKVG); bf16* YB = (bf16*)(A.ws + WS_YB);
    const int b = unit >> 6, kvh = (unit >> 5) & 1, nb = unit & 31;
    const int fr = lane & 15, fq = lane >> 4;
    const float* ROPE = (const float*)(A.ws + WS_ROPE);
    u32x4 qn0, qn1;
    const bf16* pq0;
    {
        const int g_ = wave >> 1, qh_ = wave & 1, hq_ = kvh * 4 + g_, row = lane >> 2, chunk = lane & 3;
        const size_t t = (size_t)b * SEQ + nb * 128 + qh_ * 64 + row;
        pq0 = Q + t * QW + QC_Q + hq_ * 64 + chunk * 16;
        qn0 = *(const u32x4*)pq0; qn1 = *(const u32x4*)(pq0 + 8);
    }
    LBAR();
#pragma unroll
    for (int rep = 0; rep < 2; ++rep) {
        const int task = tid + rep * 512, key = task >> 2, chunk = task & 3;
        const int s = (nb - 1) * 128 + key; const bool valid = s >= 0;
        const size_t t = (size_t)b * SEQ + (valid ? s : 0);
        float x[16];
        load_norm_rope(Q + t * QW + QC_K + kvh * 64 + chunk * 16, valid, A.kg, chunk, ROPE + t * 16, 1.0f, x);
        u32x4 o0, o1; o0.x = pk2(x[0], x[1]); o0.y = pk2(x[2], x[3]); o0.z = pk2(x[4], x[5]); o0.w = pk2(x[6], x[7]); o1.x = pk2(x[8], x[9]); o1.y = pk2(x[10], x[11]); o1.z = pk2(x[12], x[13]); o1.w = pk2(x[14], x[15]);
        *(u32x4*)(KS + key * KST + chunk * 16) = o0; *(u32x4*)(KS + key * KST + chunk * 16 + 8) = o1;
    }
#pragma unroll
    for (int rep = 0; rep < 4; ++rep) {
        const int task = tid + rep * 512, key = task >> 3, c8 = task & 7;
        const int s = (nb - 1) * 128 + key; const bool valid = s >= 0;
        const size_t t = (size_t)b * SEQ + (valid ? s : 0);
        u32x4 w = (u32x4){0, 0, 0, 0};
        if (valid) w = *(const u32x4*)(Q + t * QW + QC_V + kvh * 64 + c8 * 8);
        const unsigned ww[4] = {w.x, w.y, w.z, w.w};
        const int pkey = (((key >> 3) ^ c8) << 3) | (key & 7);
#pragma unroll
        for (int i = 0; i < 4; ++i) { VT[(c8 * 8 + 2 * i) * VST + pkey] = (bf16)(ww[i] & 0xffffu); VT[(c8 * 8 + 2 * i + 1) * VST + pkey] = (bf16)(ww[i] >> 16); }
    }
    *(u32x4*)(VT + (tid >> 3) * VST + (32 + (tid & 7)) * 8) = (u32x4){0u, 0u, 0u, 0u};
    LBAR();
    const int g = wave >> 1, qh = wave & 1, hq = kvh * 4 + g;
    const float sink = A.sinks[hq];
#pragma unroll 1
    for (int st = 0; st < 4; ++st) {
        const int q0 = qh * 64 + st * 16;
        {
            const int row = lane >> 2, chunk = lane & 3;
            const size_t t = (size_t)b * SEQ + nb * 128 + q0 + row;
            float x[16];
            const u32x4 qc0 = qn0, qc1 = qn1;
            { const bf16* pn = pq0 + (size_t)((st < 3) ? st + 1 : 3) * 16 * QW; qn0 = *(const u32x4*)pn; qn1 = *(const u32x4*)(pn + 8); }
            norm_rope(qc0, qc1, A.qg, chunk, ROPE + t * 16, 0.125f, x);
            u32x4 o0, o1; o0.x = pk2(x[0], x[1]); o0.y = pk2(x[2], x[3]); o0.z = pk2(x[4], x[5]); o0.w = pk2(x[6], x[7]); o1.x = pk2(x[8], x[9]); o1.y = pk2(x[10], x[11]); o1.z = pk2(x[12], x[13]); o1.w = pk2(x[14], x[15]);
            *(u32x4*)(QS + row * QST + chunk * 16) = o0; *(u32x4*)(QS + row * QST + chunk * 16 + 8) = o1;
        }
        LDS_WAIT();
        const bf16x8 qa0 = *(const bf16x8*)(QS + fr * QST + fq * 8), qa1 = *(const bf16x8*)(QS + fr * QST + 32 + fq * 8);
        f32x4 sc[9];
#pragma unroll
        for (int kt = 0; kt < 9; ++kt) {
            const int key = (q0 / 16 + kt) * 16 + fr;
            const bf16x8 kb0 = *(const bf16x8*)(KS + key * KST + fq * 8), kb1 = *(const bf16x8*)(KS + key * KST + 32 + fq * 8);
            f32x4 a = (f32x4){0.f, 0.f, 0.f, 0.f};
            a = __builtin_amdgcn_mfma_f32_16x16x32_bf16(qa0, kb0, a, 0, 0, 0); a = __builtin_amdgcn_mfma_f32_16x16x32_bf16(qa1, kb1, a, 0, 0, 0);
#pragma unroll
            for (int r = 0; r < 4; ++r) {
                const int qi = q0 + fq * 4 + r;
                const bool ok = (key > qi) && (key <= qi + 128) && (nb > 0 || key >= 128);
                a[r] = ok ? a[r] : -1e30f;
            }
            sc[kt] = a;
        }
        float m4[4], s4[4];
#pragma unroll
        for (int r = 0; r < 4; ++r) {
            float m = sc[0][r];
#pragma unroll
            for (int kt = 1; kt < 9; ++kt) m = fmaxf(m, sc[kt][r]);
            m = row16_max(m);
            m4[r] = fmaxf(m, sink);
            float s = 0.f;
#pragma unroll
            for (int kt = 0; kt < 9; ++kt) { const float e = __expf(sc[kt][r] - m4[r]); sc[kt][r] = e; s += e; }
            s = row16_sum(s);
            s4[r] = __builtin_amdgcn_rcpf(s + __expf(sink - m4[r]));
        }
#pragma unroll
        for (int kt = 0; kt < 9; ++kt)
#pragma unroll
            for (int r = 0; r < 4; ++r) PS[(fq * 4 + r) * PST + kt * 16 + fr] = (bf16)f2bf(sc[kt][r] * s4[r]);
#pragma unroll
        for (int r = 0; r < 4; ++r) PS[(fq * 4 + r) * PST + 144 + fr] = 0;
        LDS_WAIT();
        f32x4 o[4];
#pragma unroll
        for (int dt = 0; dt < 4; ++dt) o[dt] = (f32x4){0.f, 0.f, 0.f, 0.f};
#pragma unroll
        for (int ks = 0; ks < 5; ++ks) {
            const bf16x8 pa = *(const bf16x8*)(PS + fr * PST + ks * 32 + fq * 8);
#pragma unroll
            for (int dt = 0; dt < 4; ++dt) {
                const bf16x8 vb = *(const bf16x8*)(VT + (dt * 16 + fr) * VST + (((((q0 + ks * 32) >> 3) + fq) ^ ((dt * 2 + (fr >> 3)) & 7)) << 3));
                o[dt] = __builtin_amdgcn_mfma_f32_16x16x32_bf16(pa, vb, o[dt], 0, 0, 0);
            }
        }
        LDS_WAIT();
#pragma unroll
        for (int r = 0; r < 4; ++r)
#pragma unroll
            for (int dt = 0; dt < 4; ++dt) PS[(fq * 4 + r) * PST + dt * 16 + fr] = (bf16)f2bf(o[dt][r]);
        LDS_WAIT();
#pragma unroll
        for (int j = 0; j < 2; ++j) {
            const int tk = (lane >> 3) + 8 * j, c16 = lane & 7;
            const size_t t = (size_t)b * SEQ + nb * 128 + q0 + tk;
            *(u32x4*)(YB + t * 512 + hq * 64 + c16 * 8) = *(const u32x4*)(PS + tk * PST + c16 * 8);
        }
        LDS_WAIT();
    }
}

#define XB_TMO      128
#define XB_XCNT(j)  (256  + 64 * (j))
#define XB_XSUB(j)  (1280 + 64 * (j))
#define XB_XGEN(j)  (2304 + 64 * (j))
#define XB_TOP      3328
#define XB_TOPGEN   3392
#define XCD_BAR_WORDS 3456
#define XB_SPIN_CAP (1u << 18)

__device__ __forceinline__ unsigned xb_ld(unsigned* p)              { return __hip_atomic_load(p, __ATOMIC_RELAXED, __HIP_MEMORY_SCOPE_AGENT); }
__device__ __forceinline__ unsigned xb_add(unsigned* p, unsigned v) { return __hip_atomic_fetch_add(p, v, __ATOMIC_RELAXED, __HIP_MEMORY_SCOPE_AGENT); }
__device__ __forceinline__ unsigned xb_xcc_id() { return (unsigned)__builtin_amdgcn_s_getreg((3 << 11) | 20) & 0xFu; }
#define XB_SPIN(cond, bar) do { unsigned _sp = 0; while (cond) { __builtin_amdgcn_s_sleep(1); \
    if ((++_sp & 255u) == 0u) { if (xb_ld(&(bar)[XB_TMO])) break; if (_sp > XB_SPIN_CAP) { atomicAdd(&(bar)[XB_TMO], 1u); break; } } } } while (0)

struct XcdBarrier {
    unsigned* bar; unsigned x;
    volatile LAS unsigned* st;
};

__device__ __forceinline__ XcdBarrier xcd_barrier_post(unsigned* bar, volatile LAS unsigned* st) {
    XcdBarrier b; b.bar = bar; b.x = xb_xcc_id(); b.st = st;
    if (threadIdx.x == 0) (void)xb_add(&bar[XB_XCNT(b.x)], 1u);
    return b;
}
__device__ __forceinline__ void xcd_barrier_complete(unsigned* bar, unsigned x, unsigned& nloc, unsigned& nx) {
    const unsigned G = gridDim.x * gridDim.y * gridDim.z;
    unsigned sum, cnt, mine, sp = 0u;
    for (;;) {
        sum = 0u; cnt = 0u; mine = 0u;
#pragma unroll
        for (unsigned j = 0; j < 16; ++j) { const unsigned c = xb_ld(&bar[XB_XCNT(j)]); sum += c; cnt += (c > 0u) ? 1u : 0u; mine = (j == x) ? c : mine; }
        if (sum == G) break;
        __builtin_amdgcn_s_sleep(1);
        if ((++sp & 255u) == 0u) { if (xb_ld(&bar[XB_TMO])) break; if (sp > XB_SPIN_CAP) { atomicAdd(&bar[XB_TMO], 1u); break; } }
    }
    nloc = mine > 0u ? mine : 1u; nx = cnt > 0u ? cnt : 1u;
}

__device__ __forceinline__ void xcd_barrier(const XcdBarrier& b) {
    asm volatile("s_waitcnt vmcnt(0)" ::: "memory");
    __syncthreads();
    if (threadIdx.x == 0) {
        unsigned* bar = b.bar;
        __builtin_amdgcn_s_waitcnt(0);
        unsigned nloc = b.st[0], nx = b.st[1];
        if (nloc == 0u) { xcd_barrier_complete(bar, b.x, nloc, nx); b.st[0] = nloc; b.st[1] = nx; }
        const unsigned old = xb_add(&bar[XB_XSUB(b.x)], 1u);
        const unsigned gen = old / nloc;
        if (old + 1u == (gen + 1u) * nloc) {
            __builtin_amdgcn_fence(__ATOMIC_RELEASE, "agent");
            asm volatile("s_waitcnt vmcnt(0)" ::: "memory");
            const unsigned og = xb_add(&bar[XB_TOP], 1u);
            const unsigned tg = og / nx;
            if (og + 1u == (tg + 1u) * nx) xb_add(&bar[XB_TOPGEN], 1u);
            else XB_SPIN(xb_ld(&bar[XB_TOPGEN]) == tg, bar);
            __builtin_amdgcn_fence(__ATOMIC_ACQUIRE, "agent");
            xb_add(&bar[XB_XGEN(b.x)], 1u);
            asm volatile("s_waitcnt vmcnt(0)" ::: "memory");
        } else {
            XB_SPIN(xb_ld(&bar[XB_XGEN(b.x)]) == gen, bar);
            __builtin_amdgcn_fence(__ATOMIC_ACQUIRE, "agent");
            asm volatile("s_waitcnt vmcnt(0)" ::: "memory");
        }
    }
    __syncthreads();
}

struct Args { const void* in[29]; float* out; unsigned char* ws; };

__global__ void __launch_bounds__(512, 2) mega_fwd(Args a) {
    extern __shared__ __attribute__((aligned(16))) unsigned char lds[];
    cg::grid_group grid = cg::this_grid();
    const int wave = __builtin_amdgcn_readfirstlane(threadIdx.x >> 6);
    const int G = gridDim.x, NGW = G * 8, NGT = G * 512;
#define THREAD_IDS() const int lane = pg8::lane_id_fresh(); const int tid = wave * 64 + lane; const int gw = blockIdx.x * 8 + wave; const int gt = blockIdx.x * 512 + tid; (void)gw; (void)gt; (void)tid; (void)lane
    unsigned char* ws = a.ws;
    const float* x = (const float*)a.in[0];
    LAS unsigned char* ldsl = (LAS unsigned char*)lds;
    volatile LAS unsigned* bst = (volatile LAS unsigned*)(ldsl + LDS_BYTES - 16);
    unsigned* barw = (unsigned*)(ws + 0);
    if (threadIdx.x < 2) bst[threadIdx.x] = 0u;
    __syncthreads();
    if (a.ws == nullptr) grid.sync();
    XcdBarrier xbar = xcd_barrier_post(barw, bst);
#define GSYNC() xcd_barrier(xbar)

#ifndef REP_P0
#define REP_P0 1
#endif
#ifndef REP_P1
#define REP_P1 1
#endif
#ifndef REP_P2
#define REP_P2 1
#endif
#ifndef REP_P3
#define REP_P3 1
#endif
#ifndef REP_P4A
#define REP_P4A 1
#endif
#ifndef REP_P4B
#define REP_P4B 1
#endif
#ifndef REP_SCAN
#define REP_SCAN 1
#endif
#ifndef REP_ATT
#define REP_ATT 1
#endif
#ifndef REP_P6
#define REP_P6 1
#endif
#ifndef REP_P7
#define REP_P7 1
#endif
#ifndef REP_P8
#define REP_P8 1
#endif
#ifndef REP_P9
#define REP_P9 1
#endif
    for (int rep = 0; rep < REP_P0; ++rep) {
        THREAD_IDS();
        P0Args p{(const float*)a.in[7], (const float*)a.in[23], (const float*)a.in[24], (const float*)a.in[25], (const float*)a.in[26], (const float*)a.in[27], (const float*)a.in[28],
                 (const float*)a.in[3], (const float*)a.in[1], (const float*)a.in[10], (const float*)a.in[12], (const float*)a.in[13], ws};
        phase0(p, ldsl, gw, NGW, wave, lane, gt, NGT);
        GSYNC();
    }
#ifndef REP_SYNC
#define REP_SYNC 0
#endif
    for (int rs = 0; rs < REP_SYNC; ++rs) GSYNC();
    for (int rep = 0; rep < REP_P1; ++rep) {
        THREAD_IDS();
        const float* ada_b = (const float*)a.in[4];
        norm_mod_phase<true>(x, (const float*)a.in[5], ada_b, ws, 0, 1024, (bf16*)(ws + WS_HBUF), gw, NGW, lane);
        { const int* pos = (const int*)a.in[2]; float* rope = (float*)(ws + WS_ROPE);
          for (int i = gt; i < T * 8; i += NGT) { float cs, sn; rope_entry(pos[i >> 3], i & 7, cs, sn); rope[(size_t)(i >> 3) * 16 + (i & 7)] = cs; rope[(size_t)(i >> 3) * 16 + 8 + (i & 7)] = sn; } }
        const float* adap = (const float*)(ws + WS_ADAP); float* ada = (float*)(ws + WS_ADA);
        for (int i = gt; i < 8 * ADAW; i += NGT) { const int b = i / ADAW, j = i % ADAW; float s = ada_b[j]; for (int ks = 0; ks < KSPLIT; ++ks) s += adap[(size_t)(ks * 8 + b) * ADAW + j]; ada[i] = s; }
        GSYNC();
    }
    for (int rep = 0; rep < REP_P2; ++rep) {
        pg8::Gemm g{(const bf16*)(ws + WS_HBUF), (const bf16*)(ws + WS_WIN), T, INW, D, D}; pg8::StaticOrder S; S.init(T, INW, G, (int)blockIdx.x);
        EpiProj E{(bf16*)a.out, (bf16*)(ws + WS_QKVG), (const float*)a.in[22]};
        pg8::gemm_phase<EpiProj, pg8::StaticOrder, true, true>(ldsl, g, S, E, wave);
        GSYNC();
    }
    for (int rep = 0; rep < REP_P3; ++rep) {
        THREAD_IDS();
        P3Args p{(const bf16*)a.out, (const float*)a.in[8], (const float*)a.in[9], (const float*)a.in[11], (const float*)a.in[15], (const float*)a.in[16], ws};
        phase3(p, lds, tid, wave, lane);
        GSYNC();
    }
    for (int rep = 0; rep < REP_P4A; ++rep) {
        THREAD_IDS();
        PAArgs p{(const float*)a.in[14], (const float*)a.in[15], ws, (unsigned char*)a.out};
        ChunkRaw raw; chunk_load(p, blockIdx.x, wave, lane, raw);
        for (int it = blockIdx.x; it < 4096; it += G) {
            const ChunkRaw cur = raw;
            { const int nx = (it + G < 4096) ? it + G : it; chunk_load(p, nx, wave, lane, raw); }
            chunk_item(p, lds, it, tid, wave, lane, cur);
        }
        GSYNC();
    }
    for (int rep = 0; rep < REP_P4B; ++rep) {
        THREAD_IDS();
        if (blockIdx.x < 64) {
            PBArgs p{(const float*)a.in[17], (const float*)a.in[18], ws, (unsigned char*)a.out};
            for (int r2 = 0; r2 < REP_SCAN; ++r2) chunk_scan_m(p, lds, blockIdx.x, tid, wave, lane);
        } else {
            AtArgs p{(const float*)a.in[19], (const float*)a.in[20], (const float*)a.in[21], (const int*)a.in[2], ws};
            for (int r2 = 0; r2 < REP_ATT; ++r2) for (int u = blockIdx.x - 64; u < 512; u += G - 64) attn_unit(p, lds, u, tid, wave, lane);
        }
        GSYNC();
    }
    {
        THREAD_IDS();
        PBArgs p{(const float*)a.in[17], (const float*)a.in[18], ws, (unsigned char*)a.out};
        chunk_out(p, lds, G, wave, lane);
        GSYNC();
    }
    for (int rep = 0; rep < REP_P6; ++rep) {
        pg8::StaticOrder S; S.init(T, D, G, (int)blockIdx.x);
        { pg8::Gemm g{(const bf16*)(ws + WS_YA), (const bf16*)(ws + WS_WA), T, D, 512, 512}; EpiBranch<0> E{(const bf16*)(ws + WS_QKVG), a.out, (bf16*)(ws + WS_HBUF)};
          pg8::gemm_phase<EpiBranch<0>, pg8::StaticOrder, true, true>(ldsl, g, S, E, wave); }
        { pg8::Gemm g{(const bf16*)(ws + WS_YB), (const bf16*)(ws + WS_WB), T, D, 512, 512}; EpiBranch<1> E{(const bf16*)(ws + WS_QKVG), a.out, (bf16*)(ws + WS_HBUF)};
          pg8::gemm_phase<EpiBranch<1>, pg8::StaticOrder, true, true>(ldsl, g, S, E, wave); }
        GSYNC();
    }
    for (int rep = 0; rep < REP_P7; ++rep) {
        pg8::Gemm g{(const bf16*)(ws + WS_HBUF), (const bf16*)(ws + WS_WOUT), T, D, D, D}; pg8::StaticOrder S; S.init(T, D, G, (int)blockIdx.x);
        EpiResNorm E{x, a.out, (const float*)(ws + WS_ADA) + 2048, (const float*)(ws + WS_ADA), (const float*)a.in[6], (float*)(ws + WS_SLOT), (unsigned*)(ws + 16384), (bf16*)(ws + WS_HBUF)};
        pg8::gemm_phase<EpiResNorm, pg8::StaticOrder, true, true>(ldsl, g, S, E, wave);
        GSYNC();
    }
    for (int rep = 0; rep < REP_P8 - 1; ++rep) {
        THREAD_IDS();
        norm_mod_phase<false>(a.out, (const float*)a.in[6], (const float*)a.in[4], ws, 3072, 4096, (bf16*)(ws + WS_HBUF), gw, NGW, lane);
        GSYNC();
    }
    for (int rep = 0; rep < REP_P9; ++rep) {
        pg8::Gemm g{(const bf16*)(ws + WS_HBUF), (const bf16*)(ws + WS_W13), T, 2 * FF, D, D}; pg8::StaticOrder S; S.init(T, 2 * FF, G, (int)blockIdx.x);
        EpiSwiglu E{(bf16*)(ws + WS_QKVG)};
        pg8::gemm_phase<EpiSwiglu, pg8::StaticOrder, true, true>(ldsl, g, S, E, wave);
        GSYNC();
    }
    {
        pg8::Gemm g{(const bf16*)(ws + WS_QKVG), (const bf16*)(ws + WS_W2), T, D, FF, FF}; pg8::StaticOrder S; S.init(T, D, G, (int)blockIdx.x);
        EpiRes E{a.out, a.out, (const float*)(ws + WS_ADA) + 5120};
        pg8::gemm_phase<EpiRes, pg8::StaticOrder, true, true>(ldsl, g, S, E, wave);
    }
}

extern "C" void kernel_launch(void* const* d_in, const int* in_sizes, int n_in, void* d_out, int out_size, void* d_ws, size_t ws_size, hipStream_t stream) {
    static int grid_blocks = 0;
    if (grid_blocks == 0) {
        if (n_in != 29 || out_size != T * D || ws_size < WS_END) { fprintf(stderr, "kernel_launch: unexpected shapes (n_in %d out %d ws %zu)\n", n_in, out_size, ws_size); grid_blocks = -1; return; }
        int dev = 0, cus = 0, per_cu = 0;
        hipGetDevice(&dev);
        hipDeviceGetAttribute(&cus, hipDeviceAttributeMultiprocessorCount, dev);
        hipFuncSetAttribute((const void*)mega_fwd, hipFuncAttributeMaxDynamicSharedMemorySize, LDS_BYTES);
        hipOccupancyMaxActiveBlocksPerMultiprocessor(&per_cu, (const void*)mega_fwd, 512, LDS_BYTES);
        if (per_cu < 1) { fprintf(stderr, "kernel_launch: occupancy query gives %d\n", per_cu); per_cu = 1; }
        (void)hipGetLastError();
        grid_blocks = cus * per_cu;
    }
    if (grid_blocks < 0) return;
    if (hipMemsetAsync(d_ws, 0, 32768, stream) != hipSuccess) { fprintf(stderr, "kernel_launch: memset of the barrier words failed\n"); return; }
    Args a{};
    for (int i = 0; i < 29; ++i) a.in[i] = d_in[i];
    a.out = (float*)d_out; a.ws = (unsigned char*)d_ws;
    void* args[] = {&a};
    hipError_t e = hipLaunchCooperativeKernel((const void*)mega_fwd, dim3(grid_blocks), dim3(512), args, LDS_BYTES, stream);
    if (e != hipSuccess) fprintf(stderr, "cooperative launch failed: %s (grid %d)\n", hipGetErrorString(e), grid_blocks);
}
```
